# Optimizing an MI355X kernel written in HIP

```python
import math
import jax, jax.numpy as jnp
from jax import lax
import numpy as np

D_MODEL = 1024
BATCH = 32
SEQ = 2048
DEPTH = 1
DEC_BATCH = 2
DEC_SEQ = 16384
PAST_LEN = 128

GRID_W = 64
HEAD_DIM = 128
N_ATTN_HEADS = 4
N_KV_HEADS = 2
N_DN_HEADS = 4
DN_KDIM = 128
DN_VDIM = 128
DN_CONV_K = 5
CHUNK = 64
Q_BLOCK = 128
ROPE_THETA = 10000.0
D_FF = 2752
FFN_CONV_K = 3
EPS = 1e-6

ATTN_Q_W = N_ATTN_HEADS * HEAD_DIM
ATTN_KV_W = N_KV_HEADS * HEAD_DIM
DN_QK_W = N_DN_HEADS * DN_KDIM
DN_V_W = N_DN_HEADS * DN_VDIM
MIX_W = ATTN_Q_W + DN_V_W
IN_W = ATTN_Q_W + 2 * ATTN_KV_W + 2 * DN_QK_W + 2 * DN_V_W + 4 * N_DN_HEADS

kernel_name = "hymba_deltanet_gqa_axialrope_convffn_encoder"


def rms_norm(x, w):
    xf = x.astype(jnp.float32)
    y = xf * lax.rsqrt(jnp.mean(xf * xf, axis=-1, keepdims=True) + EPS)
    return (y * w.astype(jnp.float32)).astype(x.dtype)


def l2_norm(x):
    return x * lax.rsqrt(jnp.sum(x * x, axis=-1, keepdims=True) + EPS)


def centred_dwconv(x, w):
    K = w.shape[0]
    T = x.shape[1]
    pad = K // 2
    xp = jnp.pad(x, ((0, 0), (pad, pad), (0, 0)))
    out = xp[:, 0:T] * w[0]
    for j in range(1, K):
        out = out + xp[:, j:j + T] * w[j]
    return out


def _rope_1d(x, pos):
    d = x.shape[-1]
    inv = ROPE_THETA ** (-jnp.arange(0, d, 2, dtype=jnp.float32) / d)
    ang = pos.astype(jnp.float32)[:, None] * inv[None, :]
    cos, sin = jnp.cos(ang), jnp.sin(ang)
    x1, x2 = x[..., : d // 2], x[..., d // 2:]
    return jnp.concatenate([x1 * cos - x2 * sin, x2 * cos + x1 * sin], axis=-1)


def axial_rope(x):
    T = x.shape[2]
    rows_count = T // GRID_W
    rows = jnp.repeat(jnp.arange(rows_count, dtype=jnp.int32), GRID_W)
    cols = jnp.tile(jnp.arange(GRID_W, dtype=jnp.int32), rows_count)
    xf = x.astype(jnp.float32)
    h = x.shape[-1] // 2
    out = jnp.concatenate([_rope_1d(xf[..., :h], rows), _rope_1d(xf[..., h:], cols)], axis=-1)
    return out.astype(x.dtype)


def gqa_attention(q, k, v, q_norm_w, k_norm_w, out_norm_w):
    B, T, _ = q.shape
    G = N_ATTN_HEADS // N_KV_HEADS
    nb = T // Q_BLOCK
    q = rms_norm(q.reshape(B, T, N_ATTN_HEADS, HEAD_DIM), q_norm_w).transpose(0, 2, 1, 3)
    k = rms_norm(k.reshape(B, T, N_KV_HEADS, HEAD_DIM), k_norm_w).transpose(0, 2, 1, 3)
    v = v.reshape(B, T, N_KV_HEADS, HEAD_DIM).transpose(0, 2, 1, 3)
    q = axial_rope(q)
    k = axial_rope(k)
    qb = q.reshape(B, N_KV_HEADS, G, nb, Q_BLOCK, HEAD_DIM).transpose(3, 0, 1, 2, 4, 5)
    scale = HEAD_DIM ** -0.5

    def block(qblk):
        s = jnp.einsum('bkgqd,bksd->bkgqs', qblk, k, preferred_element_type=jnp.float32) * scale
        p = jax.nn.softmax(s, axis=-1)
        return jnp.einsum('bkgqs,bksd->bkgqd', p.astype(v.dtype), v)

    o = lax.map(block, qb)
    o = o.transpose(1, 0, 4, 2, 3, 5).reshape(B, T, N_ATTN_HEADS, HEAD_DIM)
    o = rms_norm(o, out_norm_w)
    return o.reshape(B, T, ATTN_Q_W)


def gated_delta_chunked(q, k, v, g, beta):
    B, H, T, dk = q.shape
    dv = v.shape[-1]
    N = T // CHUNK
    q = q.reshape(B, H, N, CHUNK, dk)
    k = k.reshape(B, H, N, CHUNK, dk)
    v = v.reshape(B, H, N, CHUNK, dv)
    beta = beta.reshape(B, H, N, CHUNK)
    g = jnp.cumsum(g.reshape(B, H, N, CHUNK), axis=-1)
    tril = jnp.tril(jnp.ones((CHUNK, CHUNK), dtype=bool))
    tril_strict = jnp.tril(jnp.ones((CHUNK, CHUNK), dtype=bool), -1)
    diff = g[..., :, None] - g[..., None, :]
    decay = jnp.where(tril, jnp.exp(jnp.minimum(diff, 0.0)), 0.0)
    kb = k * beta[..., None]
    vb = v * beta[..., None]
    L = jnp.where(tril_strict, jnp.einsum('bhncd,bhnsd->bhncs', kb, k) * decay, 0.0)
    a = jnp.eye(CHUNK, dtype=jnp.float32) + L
    rhs = jnp.concatenate([vb, kb * jnp.exp(g)[..., None]], axis=-1)
    sol = lax.linalg.triangular_solve(a, rhs, left_side=True, lower=True, unit_diagonal=True)
    u = sol[..., :dv]
    w = sol[..., dv:]
    attn = jnp.einsum('bhncd,bhnsd->bhncs', q, k) * decay
    qg = q * jnp.exp(g)[..., None]
    kdec = k * jnp.exp(g[..., -1:] - g)[..., None]
    glast = jnp.exp(g[..., -1])

    def step(S, xs):
        u_c, w_c, attn_c, qg_c, kdec_c, gl_c = xs
        v_new = u_c - jnp.einsum('bhcd,bhde->bhce', w_c, S)
        o_c = jnp.einsum('bhcd,bhde->bhce', qg_c, S) + jnp.einsum('bhcs,bhse->bhce', attn_c, v_new)
        S = S * gl_c[..., None, None] + jnp.einsum('bhcd,bhce->bhde', kdec_c, v_new)
        return S, o_c

    xs = (jnp.moveaxis(u, 2, 0), jnp.moveaxis(w, 2, 0), jnp.moveaxis(attn, 2, 0),
          jnp.moveaxis(qg, 2, 0), jnp.moveaxis(kdec, 2, 0), jnp.moveaxis(glast, 2, 0))
    S0 = jnp.zeros((B, H, dk, dv), jnp.float32)
    _, o = lax.scan(step, S0, xs)
    return jnp.moveaxis(o, 0, 2).reshape(B, H, T, dv)


def deltanet_mixer(q, k, v, z, a_f, a_b, b_f, b_b, conv_w, A_log_f, A_log_b, dt_bias_f, dt_bias_b, norm_w):
    B, T, _ = q.shape
    H = N_DN_HEADS
    qkv = jax.nn.silu(centred_dwconv(jnp.concatenate([q, k, v], axis=-1), conv_w))
    qkv = qkv.astype(jnp.float32)
    qh = qkv[..., :DN_QK_W].reshape(B, T, H, DN_KDIM).transpose(0, 2, 1, 3)
    kh = qkv[..., DN_QK_W:2 * DN_QK_W].reshape(B, T, H, DN_KDIM).transpose(0, 2, 1, 3)
    vh = qkv[..., 2 * DN_QK_W:].reshape(B, T, H, DN_VDIM).transpose(0, 2, 1, 3)
    qh = l2_norm(qh) * (DN_KDIM ** -0.5)
    kh = l2_norm(kh)

    def gates(a, b, A_log, dt_bias):
        a = a.astype(jnp.float32)
        g = -jnp.exp(A_log.astype(jnp.float32)) * jax.nn.softplus(a + dt_bias.astype(jnp.float32))
        beta = jax.nn.sigmoid(b.astype(jnp.float32))
        return g.transpose(0, 2, 1), beta.transpose(0, 2, 1)

    g_f, beta_f = gates(a_f, b_f, A_log_f, dt_bias_f)
    g_b, beta_b = gates(a_b, b_b, A_log_b, dt_bias_b)
    o_f = gated_delta_chunked(qh, kh, vh, g_f, beta_f)
    o_b = jnp.flip(gated_delta_chunked(jnp.flip(qh, 2), jnp.flip(kh, 2), jnp.flip(vh, 2),
                                       jnp.flip(g_b, 2), jnp.flip(beta_b, 2)), 2)
    o = (o_f + o_b).transpose(0, 2, 1, 3)
    o = rms_norm(o, norm_w) * jax.nn.silu(z.reshape(B, T, H, DN_VDIM).astype(jnp.float32))
    return o.reshape(B, T, DN_V_W).astype(q.dtype)


def encoder_layer(x, norm1_w, w_in, dn_conv_w, dn_A_log_f, dn_A_log_b, dn_dt_bias_f, dn_dt_bias_b,
                  dn_norm_w, attn_q_norm_w, attn_k_norm_w, attn_out_norm_w, w_out, norm2_w,
                  w_ffn_in, ffn_conv_w, ffn_conv_b, w_ffn_out):
    h = rms_norm(x, norm1_w)
    proj = h @ w_in
    sizes = [ATTN_Q_W, ATTN_KV_W, ATTN_KV_W, DN_QK_W, DN_QK_W, DN_V_W, DN_V_W,
             N_DN_HEADS, N_DN_HEADS, N_DN_HEADS, N_DN_HEADS]
    offsets = np.cumsum(sizes)[:-1].tolist()
    aq, ak, av, dq, dk, dv, dz, a_f, a_b, b_f, b_b = jnp.split(proj, offsets, axis=-1)
    attn_o = gqa_attention(aq, ak, av, attn_q_norm_w, attn_k_norm_w, attn_out_norm_w)
    dn_o = deltanet_mixer(dq, dk, dv, dz, a_f, a_b, b_f, b_b, dn_conv_w,
                          dn_A_log_f, dn_A_log_b, dn_dt_bias_f, dn_dt_bias_b, dn_norm_w)
    mix = jnp.concatenate([attn_o, dn_o.astype(attn_o.dtype)], axis=-1)
    x = x + mix @ w_out
    h = rms_norm(x, norm2_w)
    u = centred_dwconv(h @ w_ffn_in, ffn_conv_w) + ffn_conv_b
    gate, up = u[..., :D_FF], u[..., D_FF:]
    return x + (jax.nn.silu(gate) * up) @ w_ffn_out


def setup_inputs(seed: int = 0) -> dict:
    key = jax.random.key(seed)
    ks = jax.random.split(key, 24)
    f32 = jnp.float32
    L = DEPTH

    def nrm(k, shape, scale):
        return jax.random.normal(k, shape, f32) * scale

    def inv_softplus_dt(k):
        dt = jnp.exp(jax.random.uniform(k, (L, N_DN_HEADS), f32, math.log(1e-3), math.log(1e-1)))
        return dt + jnp.log(-jnp.expm1(-dt))

    return {
        "x_prompt": nrm(ks[0], (BATCH, SEQ, D_MODEL), 1.0),
        "x_sample": nrm(ks[1], (DEC_BATCH, DEC_SEQ, D_MODEL), 1.0),
        "norm1_w": 1.0 + nrm(ks[2], (L, D_MODEL), 0.02),
        "w_in": nrm(ks[3], (L, D_MODEL, IN_W), D_MODEL ** -0.5),
        "dn_conv_w": nrm(ks[4], (L, DN_CONV_K, 2 * DN_QK_W + DN_V_W), DN_CONV_K ** -0.5),
        "dn_A_log_f": jnp.log(jax.random.uniform(ks[5], (L, N_DN_HEADS), f32, 1.0, 16.0)),
        "dn_A_log_b": jnp.log(jax.random.uniform(ks[6], (L, N_DN_HEADS), f32, 1.0, 16.0)),
        "dn_dt_bias_f": inv_softplus_dt(ks[7]),
        "dn_dt_bias_b": inv_softplus_dt(ks[8]),
        "dn_norm_w": 1.0 + nrm(ks[9], (L, DN_VDIM), 0.02),
        "attn_q_norm_w": 1.0 + nrm(ks[10], (L, HEAD_DIM), 0.02),
        "attn_k_norm_w": 1.0 + nrm(ks[11], (L, HEAD_DIM), 0.02),
        "attn_out_norm_w": 1.0 + nrm(ks[12], (L, HEAD_DIM), 0.02),
        "w_out": nrm(ks[13], (L, MIX_W, D_MODEL), MIX_W ** -0.5),
        "norm2_w": 1.0 + nrm(ks[14], (L, D_MODEL), 0.02),
        "w_ffn_in": nrm(ks[15], (L, D_MODEL, 2 * D_FF), D_MODEL ** -0.5),
        "ffn_conv_w": nrm(ks[16], (L, FFN_CONV_K, 2 * D_FF), FFN_CONV_K ** -0.5),
        "ffn_conv_b": nrm(ks[17], (L, 2 * D_FF), 0.02),
        "w_ffn_out": nrm(ks[18], (L, D_FF, D_MODEL), D_FF ** -0.5),
    }


def reference(x_prompt, x_sample, norm1_w, w_in, dn_conv_w, dn_A_log_f, dn_A_log_b, dn_dt_bias_f,
              dn_dt_bias_b, dn_norm_w, attn_q_norm_w, attn_k_norm_w, attn_out_norm_w, w_out, norm2_w,
              w_ffn_in, ffn_conv_w, ffn_conv_b, w_ffn_out):
    def trunk(x):
        for l in range(DEPTH):
            x = encoder_layer(x, norm1_w[l], w_in[l], dn_conv_w[l], dn_A_log_f[l], dn_A_log_b[l],
                              dn_dt_bias_f[l], dn_dt_bias_b[l], dn_norm_w[l], attn_q_norm_w[l],
                              attn_k_norm_w[l], attn_out_norm_w[l], w_out[l], norm2_w[l],
                              w_ffn_in[l], ffn_conv_w[l], ffn_conv_b[l], w_ffn_out[l])
        return x

    y_prompt = trunk(x_prompt)
    y_sample = trunk(x_sample)
    return (y_prompt, y_sample)
```

```cpp
#include <hip/hip_runtime.h>
#include <hip/hip_cooperative_groups.h>
#include <cstdio>
#include <cstdint>
#include <utility>
namespace cg = cooperative_groups;

typedef unsigned short bf16_t;
typedef short bf16x8 __attribute__((ext_vector_type(8)));
typedef short s16x4 __attribute__((ext_vector_type(4)));
typedef float f32x16 __attribute__((ext_vector_type(16)));
typedef float f32x4 __attribute__((ext_vector_type(4)));
typedef float f32x2 __attribute__((ext_vector_type(2)));
typedef unsigned u32x4 __attribute__((ext_vector_type(4)));
typedef unsigned u32x2 __attribute__((ext_vector_type(2)));
typedef __bf16 bfv2 __attribute__((ext_vector_type(2)));
#define DI __device__ __forceinline__
#define MFMA32(a, b, c) __builtin_amdgcn_mfma_f32_32x32x16_bf16((a), (b), (c), 0, 0, 0)

constexpr int M_TOK = 98304, MP = 65536, DM = 1024;
constexpr int INW = 3088, INWP = 3328, DFF = 2752, DFF2 = 5504, DFF2P = 5632;
constexpr int NTHR = 512;
constexpr size_t U1 = (size_t)M_TOK * 512 * 2;
constexpr int LDS_BYTES = 163840;
constexpr int NCHUNK = M_TOK / 64;
constexpr int MSLAB = M_TOK / 2;
constexpr int DFFP = 2816;
constexpr size_t OFF_WIN = 0;
constexpr size_t OFF_WOUT = OFF_WIN + (size_t)INWP * 1024 * 2;
constexpr size_t OFF_WFFI = OFF_WOUT + (size_t)1024 * 1024 * 2;
constexpr size_t OFF_WFFO = OFF_WFFI + (size_t)DFF2P * 1024 * 2;
constexpr size_t OFF_ROPE = OFF_WFFO + (size_t)1024 * DFFP * 2;
constexpr size_t OFF_CTR = OFF_ROPE + 65536;
constexpr size_t OFF_GATES = OFF_CTR + 65536;
constexpr size_t OFF_Z = OFF_GATES + (size_t)M_TOK * 16 * 4;
constexpr size_t OFF_WC = OFF_Z + U1;
constexpr size_t OFF_UC = OFF_WC + 2 * U1;
constexpr size_t OFF_AC = OFF_UC + 2 * U1;
constexpr size_t OFF_GC = OFF_AC + U1;
constexpr size_t OFF_PROJD = OFF_GC + (size_t)NCHUNK * 8 * 64 * 4;
constexpr size_t OFF_MIX = OFF_PROJD, OFF_OF = OFF_PROJD + 2 * U1, OFF_OB = OFF_PROJD + 3 * U1;
constexpr size_t OFF_H2 = OFF_GATES;
constexpr size_t OFF_US = OFF_H2 + 2 * U1;
constexpr size_t OFF_ACT = OFF_US + (size_t)MSLAB * DFF2 * 2;
constexpr size_t OFF_SS = OFF_ACT + (size_t)MSLAB * DFFP * 2;
static_assert(OFF_SS >= OFF_PROJD + 4 * U1 && OFF_SS + (size_t)M_TOK * 4 <= 1073741824ull, "ws map");
static_assert(OFF_PROJD + 4 * U1 <= 1073741824ull, "ws map");
static_assert(OFF_ACT + (size_t)MSLAB * DFFP * 2 <= 1073741824ull, "ws map");
static_assert(OFF_WIN % 256 == 0 && OFF_GATES % 256 == 0 && OFF_PROJD % 256 == 0 && OFF_US % 256 == 0 && OFF_ACT % 256 == 0, "ws align");

struct Params {
    const float* x_prompt; const float* x_sample; const float* norm1_w; const float* w_in; const float* dn_conv_w;
    const float* A_log_f; const float* A_log_b; const float* dt_f; const float* dt_b; const float* dn_norm_w;
    const float* q_norm_w; const float* k_norm_w; const float* o_norm_w; const float* w_out; const float* norm2_w;
    const float* w_ffn_in; const float* ffn_conv_w; const float* ffn_conv_b; const float* w_ffn_out;
    float* out; char* ws;
};

DI float bf2f(bf16_t v) { return __uint_as_float(((unsigned)v) << 16); }
DI unsigned cvtpk(float lo, float hi) { f32x2 v = {lo, hi}; bfv2 r = __builtin_convertvector(v, bfv2); return __builtin_bit_cast(unsigned, r); }
DI bf16_t f2bf(float x) { return (bf16_t)(cvtpk(x, 0.f) & 0xffffu); }
DI float bflo(unsigned w) { return __uint_as_float(w << 16); }
DI float bfhi(unsigned w) { return __uint_as_float(w & 0xffff0000u); }
DI int crow(int r, int hi) { return (r & 3) + 8 * (r >> 2) + 4 * hi; }
DI float silu_f(float v) { return v * __builtin_amdgcn_rcpf(1.f + __expf(-v)); }
DI const float* xrow(const Params& p, int m) { return m < MP ? p.x_prompt + (size_t)m * DM : p.x_sample + (size_t)(m - MP) * DM; }
DI void seq_of(int m, int& base, int& t, int& T) { if (m < MP) { base = m & ~2047; t = m & 2047; T = 2048; } else { int r = m - MP; base = MP + (r & ~16383); t = r & 16383; T = 16384; } }
DI bf16x8 pack8(const f32x16& x, int s) {
    u32x4 w = {cvtpk(x[8 * s], x[8 * s + 1]), cvtpk(x[8 * s + 2], x[8 * s + 3]), cvtpk(x[8 * s + 4], x[8 * s + 5]), cvtpk(x[8 * s + 6], x[8 * s + 7])};
    return __builtin_bit_cast(bf16x8, w);
}
DI bf16x8 ld2x64(const char* p0, const char* p1) { u32x2 a = *(const u32x2*)p0, b = *(const u32x2*)p1; u32x4 w = {a.x, a.y, b.x, b.y}; return __builtin_bit_cast(bf16x8, w); }

DI void transpose_w(const float* in, int K, int N, bf16_t* out, int Kpad, int tile, char* lds, const float* kscale = nullptr) {
    float* tl = (float*)lds;
    const int nkt = Kpad / 64, tid = threadIdx.x;
    const int k0 = (tile % nkt) * 64, n0 = (tile / nkt) * 64;
    __syncthreads();
#pragma unroll
    for (int i = 0; i < 8; ++i) { int nl = tid & 63, kl = (tid >> 6) + 8 * i; int n = n0 + nl; float v = (n < N && k0 + kl < K) ? in[(size_t)(k0 + kl) * N + n] : 0.f; if (kscale) v *= kscale[k0 + kl]; tl[kl * 65 + nl] = v; }
    __syncthreads();
#pragma unroll
    for (int i = 0; i < 8; ++i) { int kl = tid & 63, nl = (tid >> 6) + 8 * i; out[(size_t)(n0 + nl) * Kpad + k0 + kl] = f2bf(tl[kl * 65 + nl]); }
}

DI void rmsnorm_rows(const Params& p, bool from_out, const float* w, bf16_t* dst) {
    const int wid = threadIdx.x >> 6, lane = threadIdx.x & 63;
    const int gw = blockIdx.x * 8 + wid, nw = gridDim.x * 8;
    f32x4 wv[4];
#pragma unroll
    for (int i = 0; i < 4; ++i) wv[i] = *(const f32x4*)(w + i * 256 + lane * 4);
    for (int m0 = gw; m0 < M_TOK; m0 += 2 * nw) {
        f32x4 v[2][4];
#pragma unroll
        for (int q = 0; q < 2; ++q) {
            const int m = min(m0 + q * nw, M_TOK - 1);
            const float* src = from_out ? (const float*)(p.out + (size_t)m * DM) : xrow(p, m);
#pragma unroll
            for (int i = 0; i < 4; ++i) v[q][i] = *(const f32x4*)(src + i * 256 + lane * 4);
        }
#pragma unroll
        for (int q = 0; q < 2; ++q) {
            const int m = m0 + q * nw;
            float ss = 0.f;
#pragma unroll
            for (int i = 0; i < 4; ++i) ss += v[q][i][0] * v[q][i][0] + v[q][i][1] * v[q][i][1] + v[q][i][2] * v[q][i][2] + v[q][i][3] * v[q][i][3];
#pragma unroll
            for (int o = 32; o >= 1; o >>= 1) ss += __shfl_xor(ss, o);
            const float rs = rsqrtf(ss * (1.f / 1024.f) + 1e-6f);
            if (m < M_TOK) {
#pragma unroll
                for (int i = 0; i < 4; ++i) {
                    u32x2 o2 = {cvtpk(v[q][i][0] * rs * wv[i][0], v[q][i][1] * rs * wv[i][1]), cvtpk(v[q][i][2] * rs * wv[i][2], v[q][i][3] * rs * wv[i][3])};
                    *(u32x2*)(dst + (size_t)m * DM + i * 256 + lane * 4) = o2;
                }
            }
        }
    }
}

__device__ const double kInvFreq[32] = {1.0, 0.7498942093324559, 0.5623413251903491, 0.4216965034285822, 0.31622776601683794, 0.23713737056616552, 0.1778279410038923, 0.1333521432163324, 0.1, 0.07498942093324558, 0.05623413251903491, 0.042169650342858224, 0.03162277660168379, 0.023713737056616554, 0.01778279410038923, 0.01333521432163324, 0.01, 0.007498942093324558, 0.005623413251903491, 0.004216965034285823, 0.0031622776601683794, 0.0023713737056616554, 0.0017782794100389228, 0.001333521432163324, 0.001, 0.0007498942093324559, 0.0005623413251903491, 0.00042169650342858224, 0.00031622776601683794, 0.00023713737056616554, 0.00017782794100389227, 0.0001333521432163324};

DI void phase0(const Params& p, char* lds) {
    char* ws = p.ws;
    const int nt0 = 16 * (INWP / 64), nt1 = 16 * 16, nt2 = 16 * (DFF2P / 64), nt3 = (DFFP / 64) * 16;
    for (int t = blockIdx.x; t < nt0 + nt1 + nt2 + nt3; t += gridDim.x) {
        if (t < nt0) transpose_w(p.w_in, 1024, INW, (bf16_t*)(ws + OFF_WIN), 1024, t, lds);
        else if (t < nt0 + nt1) transpose_w(p.w_out, 1024, 1024, (bf16_t*)(ws + OFF_WOUT), 1024, t - nt0, lds);
        else if (t < nt0 + nt1 + nt2) transpose_w(p.w_ffn_in, 1024, DFF2, (bf16_t*)(ws + OFF_WFFI), 1024, t - nt0 - nt1, lds, p.norm2_w);
        else transpose_w(p.w_ffn_out, DFF, 1024, (bf16_t*)(ws + OFF_WFFO), DFFP, t - nt0 - nt1 - nt2, lds);
    }
    if (blockIdx.x == 0 && threadIdx.x < 32) {
        const double w = kInvFreq[threadIdx.x], w2 = w * w;
        double sn = 0.0, cs = 0.0, ts = w, tc = 1.0;
        for (int k = 0; k < 12; ++k) { sn += ts; cs += tc; tc = -tc * w2 / ((2 * k + 1) * (2 * k + 2)); ts = -ts * w2 / ((2 * k + 2) * (2 * k + 3)); }
        double c = 1.0, s = 0.0; float* tab = (float*)(ws + OFF_ROPE);
        for (int pos = 0; pos < 256; ++pos) { tab[(pos * 32 + threadIdx.x) * 2] = (float)c; tab[(pos * 32 + threadIdx.x) * 2 + 1] = (float)s; double c2 = c * cs - s * sn, s2 = s * cs + c * sn; c = c2; s = s2; }
    }
    if (blockIdx.x == 0 && threadIdx.x == 64) { atomicExch((unsigned*)(ws + OFF_CTR), 0u); atomicExch((unsigned*)(ws + OFF_CTR + 1024), 0u); }
    for (int i = blockIdx.x * NTHR + threadIdx.x; i < M_TOK; i += gridDim.x * NTHR) ((float*)(ws + OFF_SS))[i] = 0.f;
    rmsnorm_rows(p, false, p.norm1_w, (bf16_t*)p.out);
}

namespace pg8 {
#define PG8_LAS __attribute__((address_space(3)))
constexpr int BM = 256, BK = 64, HALF = 128, HTB = HALF * BK * 2, STAGE_BYTES = 8 * HTB;
DI int lds_byte(int r, int c) { const int st = (r >> 4) * 2 + (c >> 5), rr = r & 15, cc = c & 31, ob = rr * 64 + cc * 2; return st * 1024 + (ob ^ (((ob >> 9) & 1) << 5)); }
DI void stage_rc(int b, int& R, int& C) { const int st = b / 1024, sb = b % 1024, swz = sb ^ (((sb >> 9) & 1) << 5); R = (st >> 1) * 16 + swz / 64; C = (st & 1) * 32 + (swz % 64) / 2; }
DI int perm32(int rho) { const int n = rho >> 4, i = rho & 15; return 8 * (i >> 2) + 4 * n + (i & 3); }
struct Unit { int pm, pn; };
struct Gemm { const bf16_t* A; const bf16_t* Bt; int M, N, K; };
struct XcdOrder {
    int nN, mpx, bpx, xcd, loc, total;
    DI void init(int mt_cnt, int nN_) { nN = nN_; mpx = mt_cnt / 8; bpx = gridDim.x / 8; xcd = blockIdx.x % 8; loc = blockIdx.x / 8; total = mpx * nN; }
    DI bool next(int i, Unit& u) const {
        const int j = loc + i * bpx; if (j >= total) return false;
        const int grp = j / (4 * nN), rem = j % (4 * nN);
        u.pm = xcd * mpx + grp * 4 + (rem & 3); u.pn = rem >> 2; return true;
    }
    DI void a_ready(const Unit&) const {}
    DI void done(const Unit&) const {}
};
template <class Epi, class Sched, bool ALIGN_EPI = false, bool SP2 = false>
__device__ __forceinline__ void gemm_phase(PG8_LAS unsigned char* lds, const Gemm g, const Sched& S, const Epi& E) {
    const int tid = threadIdx.x, wid = __builtin_amdgcn_readfirstlane(tid >> 6), lane = tid & 63, wr = wid >> 2, wc = wid & 3, fr = lane & 15, fq = lane >> 4;
    const int K = g.K, nt = K / BK;
    unsigned voffA[2], voffB[2];
#pragma unroll
    for (int i = 0; i < 2; ++i) { int R, C; stage_rc(tid * 16 + i * 8192, R, C); const int Rb = Epi::PERM ? ((R & ~31) + perm32(R & 31)) : R;
        voffA[i] = (unsigned)(R * K + C) * 2u; voffB[i] = (unsigned)(Rb * K + C) * 2u; }
    const size_t kstep = (size_t)(BK * 2);
    const size_t hstep = (size_t)HALF * K * 2;
    const size_t tstep = 2 * hstep;
    const unsigned ldsw = (unsigned)wid * 1024u;
    const int aoff = lds_byte(wr * 64 + fr, fq * 8), boff = lds_byte(wc * 32 + fr, fq * 8);
#define PG8_SA(b, h) (((b) * 2 + (h)) * HTB)
#define PG8_SB(b, h) ((4 + (b) * 2 + (h)) * HTB)
#define PG8_STAGE(bufoff, gbase, voff) do { _Pragma("unroll") for (int _i = 0; _i < 2; ++_i) \
        __builtin_amdgcn_global_load_lds((const unsigned*)((const char*)(gbase) + (voff)[_i]), (PG8_LAS unsigned*)(lds + (bufoff) + ldsw + _i * 8192), 16, 0, 0); } while (0)
#define PG8_LDA(dst, b, h) do { _Pragma("unroll") for (int m = 0; m < 4; ++m) _Pragma("unroll") for (int k = 0; k < 2; ++k) dst[m][k] = *(const PG8_LAS bf16x8*)(lds + PG8_SA(b, h) + aoff + m * 2048 + k * 1024); } while (0)
#define PG8_LDB(dst, b, h) do { _Pragma("unroll") for (int n = 0; n < 2; ++n) _Pragma("unroll") for (int k = 0; k < 2; ++k) dst[n][k] = *(const PG8_LAS bf16x8*)(lds + PG8_SB(b, h) + boff + n * 2048 + k * 1024); } while (0)
#define PG8_MMA(ai, bj, At, Bt) do { __builtin_amdgcn_s_setprio(1); _Pragma("unroll") for (int m = 0; m < 4; ++m) _Pragma("unroll") for (int n = 0; n < 2; ++n) _Pragma("unroll") for (int k = 0; k < 2; ++k) \
        acc[ai][bj][m][n] = __builtin_amdgcn_mfma_f32_16x16x32_bf16(Bt[n][k], At[m][k], acc[ai][bj][m][n], 0, 0, 0); __builtin_amdgcn_s_setprio(0); } while (0)
#define PG8_WAIT_V(n) asm volatile("s_waitcnt vmcnt(" #n ")" ::: "memory")
#define PG8_WAIT_L(n) asm volatile("s_waitcnt lgkmcnt(" #n ")" ::: "memory")
#define PG8_BAR __builtin_amdgcn_s_barrier()
#define PG8_SCHED __builtin_amdgcn_sched_barrier(0)
    Unit cur, nxt; int ui = 0;
    if (!S.next(0, cur)) return;
    f32x4 acc[2][2][4][2];
#pragma unroll
    for (int a = 0; a < 2; ++a)
#pragma unroll
        for (int b = 0; b < 2; ++b)
#pragma unroll
            for (int m = 0; m < 4; ++m)
#pragma unroll
                for (int n = 0; n < 2; ++n) acc[a][b][m][n] = (f32x4){0.f, 0.f, 0.f, 0.f};
    bf16x8 At[4][2], B0[2][2], B1[2][2];
    const char* cA = (const char*)g.A + (size_t)cur.pm * tstep; const char* cB = (const char*)g.Bt + (size_t)cur.pn * tstep;
    S.a_ready(cur);
    if constexpr (SP2) {
        PG8_STAGE(PG8_SB(0, 0), cB, voffB); PG8_STAGE(PG8_SB(0, 1), cB + hstep, voffB); PG8_STAGE(PG8_SA(0, 0), cA, voffA); PG8_STAGE(PG8_SA(0, 1), cA + hstep, voffA);
        if (wr == 1) PG8_BAR;
        PG8_WAIT_V(2); PG8_BAR;
        PG8_STAGE(PG8_SB(1, 0), cB + kstep, voffB); PG8_STAGE(PG8_SA(1, 0), cA + kstep, voffA); PG8_STAGE(PG8_SB(1, 1), cB + hstep + kstep, voffB);
        PG8_WAIT_V(6); PG8_BAR;
    } else {
        PG8_STAGE(PG8_SB(0, 0), cB, voffB); PG8_STAGE(PG8_SA(0, 0), cA, voffA); PG8_STAGE(PG8_SB(0, 1), cB + hstep, voffB); PG8_STAGE(PG8_SA(0, 1), cA + hstep, voffA);
        if (wr == 1) PG8_BAR;
        PG8_WAIT_V(4); PG8_BAR;
        PG8_STAGE(PG8_SB(1, 0), cB + kstep, voffB); PG8_STAGE(PG8_SA(1, 0), cA + kstep, voffA); PG8_STAGE(PG8_SB(1, 1), cB + hstep + kstep, voffB);
        PG8_WAIT_V(6); PG8_BAR;
    }
    for (;;) {
        const bool has_next = S.next(ui + 1, nxt);
        const char* nA = has_next ? (const char*)g.A + (size_t)nxt.pm * tstep : cA; const char* nB = has_next ? (const char*)g.Bt + (size_t)nxt.pn * tstep : cB;
        for (int t = 0; t < nt; t += 2) {
            const bool last = (t == nt - 2);
            const char* a1 = cA + (size_t)(t + 1) * kstep;
            const char* a2 = last ? nA : cA + (size_t)(t + 2) * kstep; const char* b2 = last ? nB : cB + (size_t)(t + 2) * kstep;
            const char* a3 = a2 + kstep; const char* b3 = b2 + kstep;
            if (last && has_next) S.a_ready(nxt);
            if constexpr (SP2) {
            PG8_LDB(B0, 0, 0); PG8_LDB(B1, 0, 1); PG8_SCHED; PG8_LDA(At, 0, 0); PG8_STAGE(PG8_SA(1, 1), a1 + hstep, voffA);
            PG8_WAIT_V(8); PG8_WAIT_L(0); PG8_BAR; PG8_MMA(0, 0, At, B0); PG8_MMA(0, 1, At, B1); PG8_BAR; PG8_SCHED;
            PG8_LDA(At, 0, 1); PG8_STAGE(PG8_SB(0, 0), b2, voffB); PG8_STAGE(PG8_SB(0, 1), b2 + hstep, voffB); PG8_STAGE(PG8_SA(0, 0), a2, voffA);
            PG8_WAIT_V(8); PG8_WAIT_L(0); PG8_BAR; PG8_MMA(1, 0, At, B0); PG8_MMA(1, 1, At, B1); PG8_BAR; PG8_SCHED;
            PG8_LDB(B0, 1, 0); PG8_LDB(B1, 1, 1); PG8_SCHED; PG8_LDA(At, 1, 0); PG8_STAGE(PG8_SA(0, 1), a2 + hstep, voffA);
            PG8_WAIT_V(8); PG8_WAIT_L(0); PG8_BAR; PG8_MMA(0, 0, At, B0); PG8_MMA(0, 1, At, B1); PG8_BAR; PG8_SCHED;
            PG8_LDA(At, 1, 1); PG8_STAGE(PG8_SB(1, 0), b3, voffB); PG8_STAGE(PG8_SB(1, 1), b3 + hstep, voffB); PG8_STAGE(PG8_SA(1, 0), a3, voffA);
            PG8_WAIT_V(8); PG8_WAIT_L(0); PG8_BAR; PG8_MMA(1, 0, At, B0); PG8_MMA(1, 1, At, B1); PG8_BAR; PG8_SCHED;
            } else {
            PG8_LDB(B0, 0, 0); PG8_SCHED; PG8_LDA(At, 0, 0); PG8_STAGE(PG8_SA(1, 1), a1 + hstep, voffA);
            PG8_WAIT_L(8); PG8_BAR; PG8_WAIT_L(0); PG8_MMA(0, 0, At, B0); PG8_BAR; PG8_SCHED;
            PG8_LDB(B1, 0, 1); PG8_STAGE(PG8_SB(0, 0), b2, voffB);
            PG8_BAR; PG8_WAIT_L(0); PG8_MMA(0, 1, At, B1); PG8_BAR;
            PG8_LDA(At, 0, 1); PG8_STAGE(PG8_SA(0, 0), a2, voffA);
            PG8_BAR; PG8_WAIT_L(0); PG8_MMA(1, 0, At, B0); PG8_BAR; PG8_SCHED;
            PG8_STAGE(PG8_SB(0, 1), b2 + hstep, voffB);
            PG8_WAIT_V(6); PG8_BAR; PG8_MMA(1, 1, At, B1); PG8_BAR;
            PG8_LDB(B0, 1, 0); PG8_SCHED; PG8_LDA(At, 1, 0); PG8_STAGE(PG8_SA(0, 1), a2 + hstep, voffA);
            PG8_WAIT_L(8); PG8_BAR; PG8_WAIT_L(0); PG8_MMA(0, 0, At, B0); PG8_BAR; PG8_SCHED;
            PG8_LDB(B1, 1, 1); PG8_STAGE(PG8_SB(1, 0), b3, voffB);
            PG8_BAR; PG8_WAIT_L(0); PG8_MMA(0, 1, At, B1); PG8_BAR;
            PG8_LDA(At, 1, 1); PG8_STAGE(PG8_SA(1, 0), a3, voffA);
            PG8_BAR; PG8_WAIT_L(0); PG8_MMA(1, 0, At, B0); PG8_BAR; PG8_SCHED;
            PG8_STAGE(PG8_SB(1, 1), b3 + hstep, voffB);
            PG8_WAIT_V(6); PG8_BAR; PG8_MMA(1, 1, At, B1); PG8_BAR;
            }
        }
        if constexpr (ALIGN_EPI) { if (wr == 0) PG8_BAR; }
        if constexpr (!Epi::AFTER_DRAIN) { E(acc, cur, wr, wc, fr, fq); S.done(cur); }
        if (!has_next) break;
#pragma unroll
        for (int a = 0; a < 2; ++a)
#pragma unroll
            for (int b = 0; b < 2; ++b)
#pragma unroll
                for (int m = 0; m < 4; ++m)
#pragma unroll
                    for (int n = 0; n < 2; ++n) acc[a][b][m][n] = (f32x4){0.f, 0.f, 0.f, 0.f};
        cur = nxt; cA = nA; cB = nB; ++ui;
        if constexpr (ALIGN_EPI) { if (wr == 1) PG8_BAR; }
    }
    PG8_WAIT_V(0);
    if constexpr (!ALIGN_EPI) { if (wr == 0) PG8_BAR; }
    PG8_BAR;
    if constexpr (Epi::AFTER_DRAIN) { E.fused(acc, cur, wr, wc, fr, fq, lds, wid, lane); S.done(cur); }
#undef PG8_SA
#undef PG8_SB
#undef PG8_STAGE
#undef PG8_LDA
#undef PG8_LDB
#undef PG8_MMA
#undef PG8_WAIT_V
#undef PG8_WAIT_L
#undef PG8_BAR
#undef PG8_SCHED
}

template <class F> struct EpiRows {
    static constexpr bool PERM = true, AFTER_DRAIN = false;
    F f;
    DI void operator()(const f32x4 (&acc)[2][2][4][2], const Unit& u, int wr, int wc, int fr, int fq) const {
#pragma unroll
        for (int ai = 0; ai < 2; ++ai)
#pragma unroll
            for (int m = 0; m < 4; ++m) {
                const int r = u.pm * BM + ai * HALF + wr * 64 + m * 16 + fr;
#pragma unroll
                for (int bj = 0; bj < 2; ++bj) f(r, u.pn * BM + bj * HALF + wc * 32 + 8 * fq, acc[ai][bj][m][0], acc[ai][bj][m][1]);
                asm volatile("" ::: "memory");
            }
    }
};
}

DI void st_bf8(bf16_t* p, f32x4 a, f32x4 b) { u32x4 o = {cvtpk(a[0], a[1]), cvtpk(a[2], a[3]), cvtpk(b[0], b[1]), cvtpk(b[2], b[3])}; *(u32x4*)p = o; }

struct FInProj { bf16_t* bufA; bf16_t* projD; bf16_t* bufZ; float* gates;
    DI void operator()(int m, int n0, f32x4 a, f32x4 b) const {
        if (n0 < 1024) st_bf8(bufA + (size_t)m * 1024 + n0, a, b);
        else if (n0 < 2560) st_bf8(projD + (size_t)m * 1536 + (n0 - 1024), a, b);
        else if (n0 < 3072) st_bf8(bufZ + (size_t)m * 512 + (n0 - 2560), a, b);
        else if (n0 < 3088) { float* g = gates + (size_t)m * 16 + (n0 - 3072); *(f32x4*)g = a; *(f32x4*)(g + 4) = b; }
    } };
struct FResX { const float* xp; const float* xs; float* out;
    DI void operator()(int m, int n0, f32x4 a, f32x4 b) const {
        const float* xr = (m < MP ? xp + (size_t)m * DM : xs + (size_t)(m - MP) * DM) + n0;
        const f32x4 r0 = *(const f32x4*)xr, r1 = *(const f32x4*)(xr + 4);
        float* o = out + (size_t)m * DM + n0; *(f32x4*)o = r0 + a; *(f32x4*)(o + 4) = r1 + b;
    } };
struct FU { bf16_t* us; const float* ss;
    DI void operator()(int m, int n0, f32x4 a, f32x4 b) const { if (n0 < DFF2) { const float rs = rsqrtf(ss[m] * (1.f / 1024.f) + 1e-6f); st_bf8(us + (size_t)m * DFF2 + n0, a * rs, b * rs); } } };
struct FResOut { float* out;
    DI void operator()(int m, int n0, f32x4 a, f32x4 b) const { float* o = out + (size_t)m * DM + n0; const f32x4 r0 = *(const f32x4*)o, r1 = *(const f32x4*)(o + 4); *(f32x4*)o = r0 + a; *(f32x4*)(o + 4) = r1 + b; } };

struct EpiOutProj {
    static constexpr bool PERM = true, AFTER_DRAIN = false;
    const float* xp; const float* xs; float* out; bf16_t* xb; float* ss;
    DI void operator()(const f32x4 (&acc)[2][2][4][2], const pg8::Unit& u, int wr, int wc, int fr, int fq) const {
#pragma unroll
        for (int ai = 0; ai < 2; ++ai)
#pragma unroll
            for (int m = 0; m < 4; ++m) {
                const int r = u.pm * 256 + ai * 128 + wr * 64 + m * 16 + fr;
                const float* xr = (r < MP ? xp + (size_t)r * DM : xs + (size_t)(r - MP) * DM);
                float part = 0.f;
#pragma unroll
                for (int bj = 0; bj < 2; ++bj) {
                    const int n0 = u.pn * 256 + bj * 128 + wc * 32 + 8 * fq;
                    const f32x4 v0 = *(const f32x4*)(xr + n0) + acc[ai][bj][m][0], v1 = *(const f32x4*)(xr + n0 + 4) + acc[ai][bj][m][1];
                    float* o = out + (size_t)r * DM + n0; *(f32x4*)o = v0; *(f32x4*)(o + 4) = v1;
                    st_bf8(xb + (size_t)r * DM + n0, v0, v1);
                    part += (v0[0] * v0[0] + v0[1] * v0[1]) + (v0[2] * v0[2] + v0[3] * v0[3]) + (v1[0] * v1[0] + v1[1] * v1[1]) + (v1[2] * v1[2] + v1[3] * v1[3]);
                }
                part += __shfl_xor(part, 16); part += __shfl_xor(part, 32);
                if (fq == 0) atomicAdd(ss + r, part);
                asm volatile("" ::: "memory");
            }
    }
};

template <class F> DI void run_gemm(char* lds, const bf16_t* A, const bf16_t* Bt, int K, int mt_cnt, int nN, const F& f) {
    pg8::Gemm g{A, Bt, mt_cnt * 256, nN * 256, K};
    pg8::XcdOrder S; S.init(mt_cnt, nN);
    pg8::EpiRows<F> E{f};
    pg8::gemm_phase<pg8::EpiRows<F>, pg8::XcdOrder, true, true>((PG8_LAS unsigned char*)lds, g, S, E);
}

constexpr float ASCALE = 0.088388347648318440f;
constexpr float ATHR2 = 8.f * 1.4426950408889634f;
DI void phase_attn_prep(const Params& p) {
    bf16_t* bufA = (bf16_t*)((char*)p.out + 2 * U1);
    const float* tab = (const float*)(p.ws + OFF_ROPE);
    const int j = threadIdx.x & 7;
    const int gid = (blockIdx.x * NTHR + threadIdx.x) >> 3, ng = (gridDim.x * NTHR) >> 3;
    float wq[16], wk[16];
#pragma unroll
    for (int qd_ = 0; qd_ < 4; ++qd_)
#pragma unroll
        for (int e = 0; e < 4; ++e) { wq[qd_ * 4 + e] = p.q_norm_w[qd_ * 32 + 4 * j + e]; wk[qd_ * 4 + e] = p.k_norm_w[qd_ * 32 + 4 * j + e]; }
    for (int u0 = gid; u0 < M_TOK * 6; u0 += 2 * ng) {
        u32x2 raw[2][4]; bool ok[2];
#pragma unroll
        for (int q = 0; q < 2; ++q) {
            const int u = u0 + q * ng; ok[q] = u < M_TOK * 6;
            const int uu = ok[q] ? u : 0; const int m = uu / 6, slot = uu - m * 6;
            const bf16_t* ptr = bufA + (size_t)m * 1024 + slot * 128 + 4 * j;
#pragma unroll
            for (int qd_ = 0; qd_ < 4; ++qd_) raw[q][qd_] = *(const u32x2*)(ptr + 32 * qd_);
        }
#pragma unroll
        for (int q = 0; q < 2; ++q) {
            const int u = u0 + q * ng; const int uu = ok[q] ? u : 0; const int m = uu / 6, slot = uu - m * 6;
            int base, t, T; seq_of(m, base, t, T);
            float v[16]; float ss = 0.f;
#pragma unroll
            for (int qd_ = 0; qd_ < 4; ++qd_) { v[qd_ * 4] = bflo(raw[q][qd_].x); v[qd_ * 4 + 1] = bfhi(raw[q][qd_].x); v[qd_ * 4 + 2] = bflo(raw[q][qd_].y); v[qd_ * 4 + 3] = bfhi(raw[q][qd_].y); }
#pragma unroll
            for (int e = 0; e < 16; ++e) ss += v[e] * v[e];
#pragma unroll
            for (int o = 4; o >= 1; o >>= 1) ss += __shfl_xor(ss, o);
            const float rs = rsqrtf(ss * (1.f / 128.f) + 1e-6f);
            const float rsq = slot < 4 ? rs * (ASCALE * 1.4426950408889634f) : rs;
#pragma unroll
            for (int e = 0; e < 16; ++e) v[e] = v[e] * rsq * (slot < 4 ? wq[e] : wk[e]);
            const int pr = t >> 6, pc = t & 63;
            const f32x4* tr = (const f32x4*)(tab + (pr * 32 + 4 * j) * 2); const f32x4* tc = (const f32x4*)(tab + (pc * 32 + 4 * j) * 2);
            const f32x4 r0 = tr[0], r1 = tr[1], c0 = tc[0], c1 = tc[1];
            const float cr[4] = {r0[0], r0[2], r1[0], r1[2]}, sr[4] = {r0[1], r0[3], r1[1], r1[3]};
            const float cc[4] = {c0[0], c0[2], c1[0], c1[2]}, sc[4] = {c0[1], c0[3], c1[1], c1[3]};
            float o[16];
#pragma unroll
            for (int e = 0; e < 4; ++e) {
                o[e] = v[e] * cr[e] - v[4 + e] * sr[e]; o[4 + e] = v[4 + e] * cr[e] + v[e] * sr[e];
                o[8 + e] = v[8 + e] * cc[e] - v[12 + e] * sc[e]; o[12 + e] = v[12 + e] * cc[e] + v[8 + e] * sc[e];
            }
            if (ok[q]) {
                bf16_t* ptr = bufA + (size_t)m * 1024 + slot * 128 + 4 * j;
#pragma unroll
                for (int qd_ = 0; qd_ < 4; ++qd_) *(u32x2*)(ptr + 32 * qd_) = (u32x2){cvtpk(o[qd_ * 4], o[qd_ * 4 + 1]), cvtpk(o[qd_ * 4 + 2], o[qd_ * 4 + 3])};
            }
        }
    }
}

constexpr int PL_QB = 0, PL_KB = 16896, PL_VT = 33792, PL_KT = 52224, PL_GKK = 70656, PL_LF = 70656, PL_GQK = 87040, PL_LB = 103424, PL_T = 119808, PL_SM = 156672;

template <int PI> DI void tsolve_row(float (&x)[64], const float* L, int j, f32x4 (&lc)[8], f32x4 (&ln)[8]) {
    f32x4 lh[8];
#pragma unroll
    for (int s4 = 8; s4 < (PI + 3) / 4; ++s4) lh[s4 - 8] = *(const f32x4*)(L + PI * 64 + 4 * s4);
    if (PI + 1 < 64) {
#pragma unroll
        for (int s4 = 0; s4 < (PI + 4) / 4 && s4 < 8; ++s4) ln[s4] = *(const f32x4*)(L + (PI + 1) * 64 + 4 * s4);
    }
    asm volatile("" ::: "memory");
    float a[4] = {(PI == j) ? 1.f : 0.f, 0.f, 0.f, 0.f};
#pragma unroll
    for (int s4 = 0; s4 < (PI + 3) / 4 && s4 < 8; ++s4) {
#pragma unroll
        for (int k = 0; k < 4; ++k) if (4 * s4 + k < PI) a[k] -= lc[s4][k] * x[4 * s4 + k];
    }
#pragma unroll
    for (int s4 = 8; s4 < (PI + 3) / 4; ++s4) {
#pragma unroll
        for (int k = 0; k < 4; ++k) if (4 * s4 + k < PI) a[k] -= lh[s4 - 8][k] * x[4 * s4 + k];
    }
    x[PI] = (a[0] + a[1]) + (a[2] + a[3]);
}
template <int PI> DI void tsolve_pair(float (&x)[64], const float* L, int j, f32x4 (&la)[8], f32x4 (&lb)[8]) {
    tsolve_row<2 * PI>(x, L, j, la, lb);
    tsolve_row<2 * PI + 1>(x, L, j, lb, la);
}
template <int... Is> DI void tsolve_all(float (&x)[64], const float* L, int j, std::integer_sequence<int, Is...>) {
    f32x4 la[8], lb[8];
    (tsolve_pair<Is>(x, L, j, la, lb), ...);
}
template <int... Is> DI void tstore_all(const float (&x)[64], char* TU, char* TW, float mu, float mw, std::integer_sequence<int, Is...>) {
    ((*(bf16_t*)(TU + Is * 144) = f2bf(x[Is] * mu), *(bf16_t*)(TW + Is * 144) = f2bf(x[Is] * mw)), ...);
}

DI void dn_prep_load(const Params& p, int gchunk, int h, u32x2 (&xr)[20]) {
    int tid = threadIdx.x; asm volatile("" : "+v"(tid));
    if (tid < 384) {
        const bf16_t* projD = (const bf16_t*)(p.ws + OFF_PROJD);
        const int c4 = tid & 31, grp = tid >> 5, seg = grp >> 2, tq = grp & 3;
        const int ch = seg * 512 + h * 128 + c4 * 4;
        int base, t0, T; seq_of(gchunk * 64, base, t0, T);
#pragma unroll
        for (int r = 0; r < 20; ++r) {
            const int t = t0 + tq * 16 + r - 2;
            if (t >= 0 && t < T) xr[r] = *(const u32x2*)(projD + (size_t)(base + t) * 1536 + ch);
            else xr[r] = (u32x2){0u, 0u};
        }
    }
}

DI void dn_prep_unit(const Params& p, int gchunk, int h, char* lds, u32x2 (&xr)[20], int gchunk_n, int h_n) {
    int tid_ = threadIdx.x; asm volatile("" : "+v"(tid_));
    const int tid = tid_, wid = tid >> 6, lane = tid & 63, r32 = lane & 31, hh = lane >> 5;
    char* ws = p.ws;
    const float* gates = (const float*)(ws + OFF_GATES);
    bf16_t* qd = (bf16_t*)p.out; bf16_t* kd = (bf16_t*)((char*)p.out + U1);
    const int m0 = gchunk * 64;
    int base, t0, T; seq_of(m0, base, t0, T);
    float* Gkk = (float*)(lds + PL_GKK); float* Gqk = (float*)(lds + PL_GQK);
    float* sm = (float*)(lds + PL_SM);
    __syncthreads();
#ifndef SKIP_CONV
    if (tid < 384) {
        const int c4 = tid & 31, grp = tid >> 5, seg = grp >> 2, tq = grp & 3;
        const int ch = seg * 512 + h * 128 + c4 * 4;
        f32x4 w[5];
#pragma unroll
        for (int j = 0; j < 5; ++j) w[j] = *(const f32x4*)(p.dn_conv_w + j * 1536 + ch);
        f32x4 x[20];
#pragma unroll
        for (int r = 0; r < 20; ++r) x[r] = (f32x4){bflo(xr[r].x), bfhi(xr[r].x), bflo(xr[r].y), bfhi(xr[r].y)};
        unsigned tp[4][8];
#pragma unroll
        for (int i = 0; i < 16; i += 2) {
            f32x4 yy[2];
#pragma unroll
            for (int ii = 0; ii < 2; ++ii) {
                f32x4 a = x[i + ii] * w[0];
#pragma unroll
                for (int j = 1; j < 5; ++j) a += x[i + ii + j] * w[j];
                f32x4 y = {silu_f(a[0]), silu_f(a[1]), silu_f(a[2]), silu_f(a[3])};
                const int tl = tq * 16 + i + ii;
                if (seg < 2) {
                    float ss = y[0] * y[0] + y[1] * y[1] + y[2] * y[2] + y[3] * y[3];
#pragma unroll
                    for (int o = 16; o >= 1; o >>= 1) ss += __shfl_xor(ss, o);
                    float sc = rsqrtf(ss + 1e-6f); if (seg == 0) sc *= 0.08838834764831845f;
                    y = y * sc;
                    u32x2 o2 = {cvtpk(y[0], y[1]), cvtpk(y[2], y[3])};
                    *(u32x2*)(lds + (seg == 0 ? PL_QB : PL_KB) + tl * 264 + c4 * 8) = o2;
                    *(u32x2*)((seg == 0 ? qd : kd) + (size_t)(m0 + tl) * 512 + h * 128 + c4 * 4) = o2;
                }
                yy[ii] = y;
            }
#pragma unroll
            for (int e = 0; e < 4; ++e) tp[e][i >> 1] = cvtpk(yy[0][e], yy[1][e]);
        }
        if (seg >= 1) {
            char* dstT = lds + (seg == 1 ? PL_KT : PL_VT);
#pragma unroll
            for (int e = 0; e < 4; ++e) {
                char* d = dstT + (c4 * 4 + e) * 144 + tq * 32;
                *(u32x4*)d = (u32x4){tp[e][0], tp[e][1], tp[e][2], tp[e][3]};
                *(u32x4*)(d + 16) = (u32x4){tp[e][4], tp[e][5], tp[e][6], tp[e][7]};
            }
        }
    } else
#endif
    if (tid >= 384 && tid < 512) {
        const int dir = wid - 6, pidx = lane, tl = dir ? 63 - pidx : pidx;
        const float a = gates[(size_t)(m0 + tl) * 16 + dir * 4 + h], b = gates[(size_t)(m0 + tl) * 16 + 8 + dir * 4 + h];
        const float Al = dir ? p.A_log_b[h] : p.A_log_f[h], db = dir ? p.dt_b[h] : p.dt_f[h];
        const float xx = a + db; const float sp = xx > 20.f ? xx : log1pf(expf(xx));
        float g = -expf(Al) * sp; const float beta = 1.f / (1.f + expf(-b));
#pragma unroll
        for (int o = 1; o < 64; o <<= 1) { float n = __shfl_up(g, o); if (lane >= o) g += n; }
        sm[dir * 64 + pidx] = beta; sm[128 + dir * 64 + pidx] = g; sm[256 + dir * 64 + pidx] = beta; sm[384 + dir * 64 + pidx] = beta * __expf(g);
        ((float*)(ws + OFF_GC))[((size_t)(gchunk * 4 + h) * 2 + dir) * 64 + pidx] = g;
    }
    __syncthreads();
    if (gchunk_n >= 0) dn_prep_load(p, gchunk_n, h_n, xr);
    {
        const int mat = wid >> 2, ti = (wid >> 1) & 1, tj = wid & 1;
        const char* X = lds + (mat ? PL_QB : PL_KB); const char* Kb = lds + PL_KB;
        f32x16 acc;
#pragma unroll
        for (int i = 0; i < 16; ++i) acc[i] = 0.f;
#pragma unroll
        for (int ks = 0; ks < 8; ++ks) {
            const int off = (ks * 16 + hh * 8) * 2;
            bf16x8 a = ld2x64(X + (ti * 32 + r32) * 264 + off, X + (ti * 32 + r32) * 264 + off + 8);
            bf16x8 b = ld2x64(Kb + (tj * 32 + r32) * 264 + off, Kb + (tj * 32 + r32) * 264 + off + 8);
            acc = MFMA32(a, b, acc);
        }
        float* G = mat ? Gqk : Gkk;
#pragma unroll
        for (int i = 0; i < 16; ++i) G[(ti * 32 + crow(i, hh)) * 64 + tj * 32 + r32] = acc[i];
    }
    __syncthreads();
    {
        const int dir = tid >> 8, q = tid & 255, si = q & 63, p0 = (q >> 6) * 16;
        const float* beta = sm + dir * 64; const float* gc = sm + 128 + dir * 64;
        float* L = (float*)(lds + (dir ? PL_LB : PL_LF));
        bf16_t* Ac = (bf16_t*)(ws + OFF_AC) + ((size_t)(gchunk * 4 + h) * 2 + dir) * 4096;
        const int sx = dir ? 63 - si : si; const float gs = gc[si];
        float gk[16], gq[16];
#pragma unroll
        for (int k = 0; k < 16; ++k) { const int pi = p0 + k, c = dir ? 63 - pi : pi; gk[k] = Gkk[c * 64 + sx]; gq[k] = Gqk[c * 64 + sx]; }
        __syncthreads();
#pragma unroll
        for (int k = 0; k < 16; ++k) {
            const int pi = p0 + k;
            const float dec = (si <= pi) ? __expf(gc[pi] - gs) : 0.f;
            L[pi * 64 + si] = (si < pi) ? beta[pi] * gk[k] * dec : 0.f;
            Ac[pi * 64 + si] = f2bf(gq[k] * dec);
        }
    }
    __syncthreads();
    if (tid < 128) {
        const int dir = tid >> 6, j = tid & 63;
        const float* L = (const float*)(lds + (dir ? PL_LB : PL_LF));
        float x[64];
        tsolve_all(x, L, j, std::make_integer_sequence<int, 32>{});
        const int kpos = dir ? 63 - j : j;
        char* TU = lds + PL_T + (dir * 2) * 9216 + kpos * 2; char* TW = TU + 9216;
        tstore_all(x, TU, TW, sm[256 + dir * 64 + j], sm[384 + dir * 64 + j], std::make_integer_sequence<int, 64>{});
    }
    __syncthreads();
    {
        const int dir = wid >> 2, which = (wid >> 1) & 1, half = wid & 1;
        const char* Ta = lds + PL_T + (dir * 2 + which) * 9216;
        const char* Bm = lds + (which ? PL_KT : PL_VT);
        const size_t ci = (size_t)(gchunk * 4 + h) * 2 + dir;
        f32x16 acc[2][2];
#pragma unroll
        for (int a = 0; a < 2; ++a)
#pragma unroll
            for (int b = 0; b < 2; ++b)
#pragma unroll
                for (int i = 0; i < 16; ++i) acc[a][b][i] = 0.f;
#pragma unroll
        for (int ks = 0; ks < 4; ++ks) {
            const int ko = (ks * 16 + hh * 8) * 2;
            bf16x8 af[2], bfr[2];
#pragma unroll
            for (int pt = 0; pt < 2; ++pt) af[pt] = *(const bf16x8*)(Ta + (pt * 32 + r32) * 144 + ko);
#pragma unroll
            for (int ct = 0; ct < 2; ++ct) bfr[ct] = *(const bf16x8*)(Bm + (half * 64 + ct * 32 + r32) * 144 + ko);
#pragma unroll
            for (int pt = 0; pt < 2; ++pt)
#pragma unroll
                for (int ct = 0; ct < 2; ++ct) acc[pt][ct] = MFMA32(af[pt], bfr[ct], acc[pt][ct]);
        }
        if (which == 0) {
            bf16_t* Uc = (bf16_t*)(ws + OFF_UC) + ci * 8192;
#pragma unroll
            for (int pt = 0; pt < 2; ++pt)
#pragma unroll
                for (int ct = 0; ct < 2; ++ct) {
                    const f32x16& a = acc[pt][ct];
                    u32x4* d = (u32x4*)(Uc + (((half * 2 + ct) * 2 + pt) * 64 + lane) * 16);
                    d[0] = (u32x4){cvtpk(a[0], a[1]), cvtpk(a[2], a[3]), cvtpk(a[4], a[5]), cvtpk(a[6], a[7])};
                    d[1] = (u32x4){cvtpk(a[8], a[9]), cvtpk(a[10], a[11]), cvtpk(a[12], a[13]), cvtpk(a[14], a[15])};
                }
        } else {
            bf16_t* Wc = (bf16_t*)(ws + OFF_WC) + ci * 8192;
#pragma unroll
            for (int pt = 0; pt < 2; ++pt)
#pragma unroll
                for (int ct = 0; ct < 2; ++ct)
#pragma unroll
                    for (int i = 0; i < 16; ++i) Wc[(pt * 32 + crow(i, hh)) * 128 + half * 64 + ct * 32 + r32] = f2bf(-acc[pt][ct][i]);
        }
    }
}

constexpr int SL_W = 0, SL_QG = 16896, SL_KDT = 33792, SL_AT = 51200, SL_BUF = 59904;

DI void dn_scan_item(const Params& p, int seqbase, int T, int h, int dir, char* lds) {
    int tid_ = threadIdx.x; asm volatile("" : "+v"(tid_));
    const int tid = tid_, wid = __builtin_amdgcn_readfirstlane(tid >> 6), lane0 = tid & 63;
    char* ws = p.ws;
    const int N = T >> 6, gch0 = seqbase >> 6;
    const bf16_t* qd = (const bf16_t*)p.out; const bf16_t* kd = (const bf16_t*)((char*)p.out + U1);
    const bf16_t* WcB = (const bf16_t*)(ws + OFF_WC); const bf16_t* UcB = (const bf16_t*)(ws + OFF_UC);
    const bf16_t* AcB = (const bf16_t*)(ws + OFF_AC); const float* GcB = (const float*)(ws + OFF_GC);
    bf16_t* Oout = (bf16_t*)(ws + (dir ? OFF_OB : OFF_OF));
    const bool loader = wid >= 4;
    const int lt0 = tid - 256;

    struct LRegs { u32x4 rw[4], rq[4], rk[4], rat[2]; float gq[4]; float glast; };
    auto issue = [&](int n, LRegs& R) {
        int lt = lt0; asm volatile("" : "+v"(lt));
        const int cn = dir ? N - 1 - n : n; const int gchunk = gch0 + cn;
        const size_t ci = (size_t)(gchunk * 4 + h) * 2 + dir;
        const bf16_t* Wc = WcB + ci * 8192; const bf16_t* Ac = AcB + ci * 4096; const float* gc = GcB + ci * 64;
        R.glast = gc[63];
#pragma unroll
        for (int i = 0; i < 4; ++i) {
            const int q = lt + 256 * i, row = q >> 4, c16 = q & 15;
            const int tl = dir ? 63 - row : row; const size_t m = (size_t)gchunk * 64 + tl;
            R.rw[i] = *(const u32x4*)(Wc + row * 128 + c16 * 8);
            R.rq[i] = *(const u32x4*)(qd + m * 512 + h * 128 + c16 * 8);
            R.rk[i] = *(const u32x4*)(kd + m * 512 + h * 128 + c16 * 8);
            R.gq[i] = gc[row];
        }
#pragma unroll
        for (int i = 0; i < 2; ++i) { const int q = lt + 256 * i, row = q >> 3, c16 = q & 7; R.rat[i] = *(const u32x4*)(Ac + row * 64 + c16 * 8); }
    };
    auto commit = [&](int par, const LRegs& R) {
        int lt = lt0; asm volatile("" : "+v"(lt));
        char* buf = lds + par * SL_BUF;
#pragma unroll
        for (int i = 0; i < 4; ++i) {
            const int q = lt + 256 * i, row = q >> 4, c16 = q & 15;
            char* wd = buf + SL_W + row * 264 + c16 * 16;
            *(u32x2*)wd = (u32x2){R.rw[i].x, R.rw[i].y}; *(u32x2*)(wd + 8) = (u32x2){R.rw[i].z, R.rw[i].w};
            const float eq = __expf(R.gq[i]), ek = __expf(R.glast - R.gq[i]);
            unsigned qq[4] = {R.rq[i].x, R.rq[i].y, R.rq[i].z, R.rq[i].w}, kk[4] = {R.rk[i].x, R.rk[i].y, R.rk[i].z, R.rk[i].w};
            unsigned qo[4];
#pragma unroll
            for (int e = 0; e < 4; ++e) qo[e] = cvtpk(bflo(qq[e]) * eq, bfhi(qq[e]) * eq);
            char* qdst = buf + SL_QG + row * 264 + c16 * 16;
            *(u32x2*)qdst = (u32x2){qo[0], qo[1]}; *(u32x2*)(qdst + 8) = (u32x2){qo[2], qo[3]};
#pragma unroll
            for (int e = 0; e < 4; ++e) {
                const unsigned pk = cvtpk(bflo(kk[e]) * ek, bfhi(kk[e]) * ek);
                *(bf16_t*)(buf + SL_KDT + (c16 * 8 + 2 * e) * 136 + row * 2) = (bf16_t)(pk & 0xffffu);
                *(bf16_t*)(buf + SL_KDT + (c16 * 8 + 2 * e + 1) * 136 + row * 2) = (bf16_t)(pk >> 16);
            }
        }
#pragma unroll
        for (int i = 0; i < 2; ++i) {
            const int q = lt + 256 * i, row = q >> 3, c16 = q & 7;
            char* ad = buf + SL_AT + row * 136 + c16 * 16;
            *(u32x2*)ad = (u32x2){R.rat[i].x, R.rat[i].y}; *(u32x2*)(ad + 8) = (u32x2){R.rat[i].z, R.rat[i].w};
        }
    };

    f32x16 S[4];
#pragma unroll
    for (int d = 0; d < 4; ++d)
#pragma unroll
        for (int i = 0; i < 16; ++i) S[d][i] = 0.f;
    const int slab = wid & 3;
    struct URegs { u32x4 un[2][2]; float gl; };
    auto uload = [&](int n, URegs& U) {
        int lane = lane0; asm volatile("" : "+v"(lane));
        const int cn = dir ? N - 1 - n : n; const size_t ci = (size_t)((gch0 + cn) * 4 + h) * 2 + dir;
        const bf16_t* Uc = UcB + ci * 8192;
#pragma unroll
        for (int pt = 0; pt < 2; ++pt) { const u32x4* sp = (const u32x4*)(Uc + ((slab * 2 + pt) * 64 + lane) * 16); U.un[pt][0] = sp[0]; U.un[pt][1] = sp[1]; }
        U.gl = GcB[ci * 64 + 63];
    };
    auto compute = [&](int n, int par, URegs& U) {
        int lane = lane0; asm volatile("" : "+v"(lane));
        const int r32 = lane & 31, hh = lane >> 5;
        const char* buf = lds + par * SL_BUF;
        f32x16 vn[2], o[2];
#pragma unroll
        for (int pt = 0; pt < 2; ++pt) {
            const unsigned uu[8] = {U.un[pt][0].x, U.un[pt][0].y, U.un[pt][0].z, U.un[pt][0].w, U.un[pt][1].x, U.un[pt][1].y, U.un[pt][1].z, U.un[pt][1].w};
#pragma unroll
            for (int e = 0; e < 8; ++e) { vn[pt][2 * e] = bflo(uu[e]); vn[pt][2 * e + 1] = bfhi(uu[e]); }
#pragma unroll
            for (int i = 0; i < 16; ++i) o[pt][i] = 0.f;
        }
        const float gl = __expf(U.gl);
        if (n + 2 < N) uload(n + 2, U);
#pragma unroll
        for (int ks = 0; ks < 8; ++ks) {
            const bf16x8 sb = pack8(S[ks >> 1], ks & 1);
            const int off = (ks * 16 + 4 * hh) * 2;
#pragma unroll
            for (int pt = 0; pt < 2; ++pt) {
                const char* wr = buf + SL_W + (pt * 32 + r32) * 264 + off;
                const char* qr = buf + SL_QG + (pt * 32 + r32) * 264 + off;
                vn[pt] = MFMA32(ld2x64(wr, wr + 16), sb, vn[pt]);
                o[pt] = MFMA32(ld2x64(qr, qr + 16), sb, o[pt]);
            }
        }
        bf16x8 vb[4];
#pragma unroll
        for (int kp = 0; kp < 4; ++kp) vb[kp] = pack8(vn[kp >> 1], kp & 1);
#pragma unroll
        for (int d = 0; d < 4; ++d) S[d] = S[d] * gl;
#pragma unroll
        for (int kp = 0; kp < 4; ++kp) {
            const int off = (kp * 16 + 4 * hh) * 2;
#pragma unroll
            for (int pt = 0; pt < 2; ++pt) { const char* ar = buf + SL_AT + (pt * 32 + r32) * 136 + off; o[pt] = MFMA32(ld2x64(ar, ar + 16), vb[kp], o[pt]); }
#pragma unroll
            for (int d = 0; d < 4; ++d) { const char* kr = buf + SL_KDT + (d * 32 + r32) * 136 + off; S[d] = MFMA32(ld2x64(kr, kr + 16), vb[kp], S[d]); }
        }
        const int cn = dir ? N - 1 - n : n; const size_t mrow0 = (size_t)(gch0 + cn) * 64;
#pragma unroll
        for (int pt = 0; pt < 2; ++pt)
#pragma unroll
            for (int i = 0; i < 16; ++i) {
                const int pi = pt * 32 + crow(i, hh), tl = dir ? 63 - pi : pi;
                Oout[(mrow0 + tl) * 512 + h * 128 + slab * 32 + r32] = f2bf(o[pt][i]);
            }
    };
    __syncthreads();
    if (loader) {
        LRegs RA, RB;
        issue(0, RA); issue(1, RB); commit(0, RA); issue(2, RA);
        __syncthreads();
        for (int n = 0; n < N; n += 2) {
            commit(1, RB); if (n + 3 < N) issue(n + 3, RB);
            __syncthreads();
            if (n + 2 < N) { commit(0, RA); if (n + 4 < N) issue(n + 4, RA); }
            __syncthreads();
        }
    } else {
        URegs UA, UB;
        uload(0, UA); uload(1, UB);
        __syncthreads();
        for (int n = 0; n < N; n += 2) {
            compute(n, 0, UA);
            __syncthreads();
            compute(n + 1, 1, UB);
            __syncthreads();
        }
    }
}

constexpr int LDA_ = 1024, LDO_ = 1024;
constexpr size_t SHM_V = 64 * 128 * 2, SHM_K = 64 * 128 * 2;
#define KSWZ(row, colB) ((row) * 256 + ((colB) ^ (((row) & 7) << 4)))
#define SBAR() __builtin_amdgcn_sched_barrier(0)

DI unsigned cvtpk_a(float lo, float hi) { unsigned r; asm volatile("v_cvt_pk_bf16_f32 %0, %1, %2" : "=v"(r) : "v"(lo), "v"(hi)); return r; }
template <bool FIRST> DI void partialSM(f32x16& p0, f32x16& p1, float& m_reg, float& alpha) {
    float pmax = p0[0];
#pragma unroll
    for (int r = 1; r < 16; ++r) pmax = fmaxf(pmax, p0[r]);
#pragma unroll
    for (int r = 0; r < 16; ++r) pmax = fmaxf(pmax, p1[r]);
    { auto rr = __builtin_amdgcn_permlane32_swap(__float_as_uint(pmax), __float_as_uint(pmax), false, false);
      pmax = fmaxf(__uint_as_float(rr[0]), __uint_as_float(rr[1])); }
    if (!FIRST && __builtin_expect(__all(pmax <= ATHR2), 1)) { alpha = 1.f; }
    else {
        const float delta = FIRST ? pmax : fmaxf(pmax, 0.f);
        alpha = __builtin_amdgcn_exp2f(-delta); m_reg += delta;
#pragma unroll
        for (int r = 0; r < 16; ++r) { p0[r] -= delta; p1[r] -= delta; }
    }
#pragma unroll
    for (int r = 0; r < 16; ++r) p0[r] = __builtin_amdgcn_exp2f(p0[r]);
}
DI void finishSM(f32x16& p0, f32x16& p1, float alpha, float& l_reg, bf16x8& pa0, bf16x8& pa1, bf16x8& pa2, bf16x8& pa3) {
#pragma unroll
    for (int r = 0; r < 16; ++r) p1[r] = __builtin_amdgcn_exp2f(p1[r]);
    float ps = 0;
#pragma unroll
    for (int r = 0; r < 16; ++r) ps += p0[r];
#pragma unroll
    for (int r = 0; r < 16; ++r) ps += p1[r];
    { auto rr = __builtin_amdgcn_permlane32_swap(__float_as_uint(ps), __float_as_uint(ps), false, false);
      ps = __uint_as_float(rr[0]) + __uint_as_float(rr[1]); }
    l_reg = l_reg * alpha + ps;
#define PK4(P, BASE, OUT) do { unsigned a0 = cvtpk_a(P[BASE + 0], P[BASE + 1]), a1 = cvtpk_a(P[BASE + 2], P[BASE + 3]);   \
    unsigned b0 = cvtpk_a(P[BASE + 4], P[BASE + 5]), b1 = cvtpk_a(P[BASE + 6], P[BASE + 7]);                              \
    auto r0 = __builtin_amdgcn_permlane32_swap(a0, b0, false, false); auto r1 = __builtin_amdgcn_permlane32_swap(a1, b1, false, false); \
    u32x4 w = {r0[0], r1[0], r0[1], r1[1]}; OUT = __builtin_bit_cast(bf16x8, w); } while (0)
    PK4(p0, 0, pa0); PK4(p0, 8, pa1); PK4(p1, 0, pa2); PK4(p1, 8, pa3);
#undef PK4
}
DI void qkt(f32x16& p0, f32x16& p1, const char* Ks, const bf16x8* qr, float negm, int r32, int hi) {
#pragma unroll
    for (int i = 0; i < 16; ++i) { p0[i] = negm; p1[i] = negm; }
#pragma unroll
    for (int d0 = 0; d0 < 8; ++d0) { const int cb = (d0 * 16 + hi * 8) * 2;
        bf16x8 b0 = *(const bf16x8*)(Ks + KSWZ(r32, cb));
        bf16x8 b1 = *(const bf16x8*)(Ks + KSWZ(32 + r32, cb));
        p0 = MFMA32(b0, qr[d0], p0);
        p1 = MFMA32(b1, qr[d0], p1); }
}
DI int v_st(int k, int c) { const int kk = (k & ~0xC) | ((k & 4) << 1) | ((k & 8) >> 1); return ((kk >> 3) * 4 + (c >> 5)) * 512 + ((kk & 7) * 32 + (c & 31)) * 2; }
DI int v_rd_base(int lane) { return ((lane & 3) << 3) | (((lane >> 2) & 3) << 6) | (((lane >> 4) & 1) << 5) | (((lane >> 5) & 1) << 8); }
constexpr int v_rd_off(int d0, int ks, int half) { return d0 * 512 + ks * 4096 + half * 2048; }
template <int OFF> DI s16x4 tr_read(int vb) { s16x4 r; asm volatile("ds_read_b64_tr_b16 %0, %1 offset:%2" : "=&v"(r) : "v"(vb), "i"(OFF) : "memory"); return r; }
template <int D0> DI void pv_one(f32x16& od, int vb, bf16x8 pa0, bf16x8 pa1, bf16x8 pa2, bf16x8 pa3) {
    const s16x4 l0 = tr_read<v_rd_off(D0, 0, 0)>(vb), h0 = tr_read<v_rd_off(D0, 0, 1)>(vb), l1 = tr_read<v_rd_off(D0, 1, 0)>(vb), h1 = tr_read<v_rd_off(D0, 1, 1)>(vb);
    const s16x4 l2 = tr_read<v_rd_off(D0, 2, 0)>(vb), h2 = tr_read<v_rd_off(D0, 2, 1)>(vb), l3 = tr_read<v_rd_off(D0, 3, 0)>(vb), h3 = tr_read<v_rd_off(D0, 3, 1)>(vb);
    asm volatile("s_waitcnt lgkmcnt(0)" ::: "memory"); SBAR();
#define PK(L, H) (bf16x8){L[0], L[1], L[2], L[3], H[0], H[1], H[2], H[3]}
    od = MFMA32(pa0, PK(l0, h0), od);
    od = MFMA32(pa1, PK(l1, h1), od);
    od = MFMA32(pa2, PK(l2, h2), od);
    od = MFMA32(pa3, PK(l3, h3), od);
#undef PK
}
DI void pv_d0(f32x16* o, int vb, bf16x8 pa0, bf16x8 pa1, bf16x8 pa2, bf16x8 pa3) {
    pv_one<0>(o[0], vb, pa0, pa1, pa2, pa3); pv_one<1>(o[1], vb, pa0, pa1, pa2, pa3); pv_one<2>(o[2], vb, pa0, pa1, pa2, pa3); pv_one<3>(o[3], vb, pa0, pa1, pa2, pa3);
}

DI void attn_unit(const bf16_t* __restrict__ Qb, const bf16_t* __restrict__ Kh, const bf16_t* __restrict__ Vh, bf16_t* __restrict__ Ob, const float* __restrict__ onw, int seq, char* lds) {
    int tid_ = threadIdx.x; asm volatile("" : "+v"(tid_));
    const int tid = tid_, wid = tid >> 6, lane = tid & 63, r32 = lane & 31, hi = lane >> 5;
    char* V_lds = lds; char* K_lds = lds + 2 * SHM_V;
    float* wsf = (float*)(lds + 2 * SHM_V + 2 * SHM_K) + wid * 64; float* li_l = wsf; float* al_l = wsf + 32;
    float m_reg = 0.f, l_reg = 0; f32x16 o[4]; bf16x8 qr[8];
#pragma unroll
    for (int d = 0; d < 4; ++d)
#pragma unroll
        for (int i = 0; i < 16; ++i) o[d][i] = 0.f;
    const bf16_t* Qw = Qb + (long)((wid & 3) * 32 + r32) * LDA_ + (wid >> 2) * 128 + hi * 8;
#pragma unroll
    for (int d0 = 0; d0 < 8; ++d0) qr[d0] = *(const bf16x8*)(Qw + d0 * 16);
    const int sr = tid >> 4, sc = (tid & 15) * 8, vst0 = v_st(sr, sc), vst1 = v_st(32 + sr, sc);
    const int vb0 = (int)(uintptr_t)V_lds + v_rd_base(lane);
    struct { bf16x8 vs0, vs1, ks0, ks1; } sr_[1];
#define SLOAD(i, k0) do { sr_[i].vs0 = *(const bf16x8*)(&Vh[(long)((k0) + sr) * LDA_ + sc]); sr_[i].vs1 = *(const bf16x8*)(&Vh[(long)((k0) + 32 + sr) * LDA_ + sc]); \
    sr_[i].ks0 = *(const bf16x8*)(&Kh[(long)((k0) + sr) * LDA_ + sc]); sr_[i].ks1 = *(const bf16x8*)(&Kh[(long)((k0) + 32 + sr) * LDA_ + sc]); } while (0)
#define SWRITE(b, i) do { *(bf16x8*)(V_lds + (b) * SHM_V + vst0) = sr_[i].vs0;          \
    *(bf16x8*)(V_lds + (b) * SHM_V + vst1) = sr_[i].vs1; int kc = sc * 2;               \
    *(bf16x8*)(K_lds + (b) * SHM_K + KSWZ(sr, kc)) = sr_[i].ks0;                       \
    *(bf16x8*)(K_lds + (b) * SHM_K + KSWZ(32 + sr, kc)) = sr_[i].ks1; } while (0)
#define SWAIT() asm volatile("s_waitcnt vmcnt(0)" ::: "memory")
#define RESC(a) do { if (__any((a) < 1.f)) { if (hi == 0) al_l[r32] = (a); asm volatile("s_waitcnt lgkmcnt(0)" ::: "memory"); \
    _Pragma("unroll") for (int d = 0; d < 4; ++d) _Pragma("unroll") for (int r = 0; r < 16; ++r) o[d][r] *= al_l[crow(r, hi)]; } } while (0)
    f32x16 pA0, pA1, pB0, pB1; float alA, alB; bf16x8 pa0, pa1, pa2, pa3; const int NT = seq / 64;
    constexpr int SE = 0, SO = 0;
    SLOAD(SE, 0); asm volatile("s_waitcnt vmcnt(0)" ::: "memory"); SWRITE(0, SE); __syncthreads();
    qkt(pA0, pA1, K_lds, qr, 0.f, r32, hi); partialSM<true>(pA0, pA1, m_reg, alA);
    SLOAD(SO, 64);
    SWAIT(); SWRITE(1, SO); __syncthreads();
    for (int j = 1; j + 1 < NT; j += 2) {
        SBAR(); qkt(pB0, pB1, K_lds + SHM_K, qr, -m_reg, r32, hi);
        finishSM(pA0, pA1, alA, l_reg, pa0, pa1, pa2, pa3); SBAR();
        SLOAD(SO, (j + 1) * 64); SBAR();
        pv_d0(o, vb0, pa0, pa1, pa2, pa3); partialSM<false>(pB0, pB1, m_reg, alB);
        __syncthreads(); SWAIT(); SWRITE(0, SE);
        RESC(alB); __syncthreads();
        SBAR(); qkt(pA0, pA1, K_lds, qr, -m_reg, r32, hi);
        finishSM(pB0, pB1, alB, l_reg, pa0, pa1, pa2, pa3); SBAR();
        SLOAD(SE, (j + 2) * 64); SBAR();
        pv_d0(o, vb0 + (int)SHM_V, pa0, pa1, pa2, pa3); partialSM<false>(pA0, pA1, m_reg, alA);
        __syncthreads(); SWAIT(); SWRITE(1, SO);
        RESC(alA); __syncthreads();
    }
    SBAR(); qkt(pB0, pB1, K_lds + SHM_K, qr, -m_reg, r32, hi);
    finishSM(pA0, pA1, alA, l_reg, pa0, pa1, pa2, pa3); SBAR();
    pv_d0(o, vb0, pa0, pa1, pa2, pa3); partialSM<false>(pB0, pB1, m_reg, alB);
    __syncthreads(); RESC(alB);
    finishSM(pB0, pB1, alB, l_reg, pa0, pa1, pa2, pa3); SBAR();
    pv_d0(o, vb0 + (int)SHM_V, pa0, pa1, pa2, pa3);
    if (hi == 0) li_l[r32] = l_reg; asm volatile("s_waitcnt lgkmcnt(0)" ::: "memory");
    float wn[4];
#pragma unroll
    for (int d0 = 0; d0 < 4; ++d0) wn[d0] = onw[d0 * 32 + r32];
    bf16_t* Ow = Ob + (long)((wid & 3) * 32) * LDO_ + (wid >> 2) * 128;
#pragma unroll
    for (int r = 0; r < 16; ++r) {
        const int orow = crow(r, hi);
        const float rl = __builtin_amdgcn_rcpf(li_l[orow]);
        float v[4]; float ss = 0.f;
#pragma unroll
        for (int d0 = 0; d0 < 4; ++d0) { v[d0] = o[d0][r] * rl; ss += v[d0] * v[d0]; }
#pragma unroll
        for (int of = 16; of >= 1; of >>= 1) ss += __shfl_xor(ss, of);
        const float rs = rsqrtf(ss * (1.f / 128.f) + 1e-6f);
#pragma unroll
        for (int d0 = 0; d0 < 4; ++d0) Ow[(long)orow * LDO_ + d0 * 32 + r32] = f2bf(v[d0] * rs * wn[d0]);
    }
#undef SLOAD
#undef SWRITE
#undef SWAIT
#undef RESC
}

DI void phase_dn_combine(const Params& p) {
    char* ws = p.ws;
    const bf16_t* of = (const bf16_t*)(ws + OFF_OF); const bf16_t* ob = (const bf16_t*)(ws + OFF_OB); const bf16_t* z = (const bf16_t*)(ws + OFF_Z);
    bf16_t* mix = (bf16_t*)(ws + OFF_MIX);
    const int j = threadIdx.x & 15;
    const int gid = (blockIdx.x * NTHR + threadIdx.x) >> 4, ng = (gridDim.x * NTHR) >> 4;
    float nw[8];
#pragma unroll
    for (int e = 0; e < 8; ++e) nw[e] = p.dn_norm_w[j * 8 + e];
    for (int u0 = gid; u0 < M_TOK * 4; u0 += 2 * ng) {
        u32x4 a[2], b[2], zz[2]; bool ok[2];
#pragma unroll
        for (int q = 0; q < 2; ++q) {
            const int u = u0 + q * ng; ok[q] = u < M_TOK * 4;
            if (ok[q]) { const size_t off = (size_t)u * 128 + j * 8; a[q] = *(const u32x4*)(of + off); b[q] = *(const u32x4*)(ob + off); zz[q] = *(const u32x4*)(z + off); }
            else { a[q] = (u32x4){0u, 0u, 0u, 0u}; b[q] = a[q]; zz[q] = a[q]; }
        }
#pragma unroll
        for (int q = 0; q < 2; ++q) {
            const int u = u0 + q * ng;
            const unsigned aa[4] = {a[q].x, a[q].y, a[q].z, a[q].w}, bb[4] = {b[q].x, b[q].y, b[q].z, b[q].w}, zq[4] = {zz[q].x, zz[q].y, zz[q].z, zz[q].w};
            float v[8], zf[8]; float ss = 0.f;
#pragma unroll
            for (int e = 0; e < 4; ++e) { v[2 * e] = bflo(aa[e]) + bflo(bb[e]); v[2 * e + 1] = bfhi(aa[e]) + bfhi(bb[e]); zf[2 * e] = bflo(zq[e]); zf[2 * e + 1] = bfhi(zq[e]); }
#pragma unroll
            for (int e = 0; e < 8; ++e) ss += v[e] * v[e];
#pragma unroll
            for (int o = 8; o >= 1; o >>= 1) ss += __shfl_xor(ss, o);
            const float rs = rsqrtf(ss * (1.f / 128.f) + 1e-6f);
            float r[8];
#pragma unroll
            for (int e = 0; e < 8; ++e) r[e] = v[e] * rs * nw[e] * silu_f(zf[e]);
            if (ok[q]) *(u32x4*)(mix + (size_t)(u >> 2) * 1024 + 512 + (u & 3) * 128 + j * 8) = (u32x4){cvtpk(r[0], r[1]), cvtpk(r[2], r[3]), cvtpk(r[4], r[5]), cvtpk(r[6], r[7])};
        }
    }
}

DI void phase_ffn_act(const Params& p, int slab) {
    char* ws = p.ws;
    const bf16_t* us = (const bf16_t*)(ws + OFF_US); bf16_t* act = (bf16_t*)(ws + OFF_ACT);
    constexpr int NG = DFFP / 8;
    const int nthreads = gridDim.x * NTHR, tpg = nthreads / NG;
    const int gt = blockIdx.x * NTHR + threadIdx.x, cg8 = gt % NG, sidx = gt / NG;
    if (sidx >= tpg) return;
    const int seglen = (MSLAB + tpg - 1) / tpg;
    const int t_beg = sidx * seglen, t_end = min(MSLAB, t_beg + seglen);
    const int c8 = cg8 * 8, m0 = slab * MSLAB;
    if (c8 >= DFF) { for (int ml = t_beg; ml < t_end; ++ml) *(u32x4*)(act + (size_t)ml * DFFP + c8) = (u32x4){0u, 0u, 0u, 0u}; return; }
    float wg[3][8], wu[3][8], bg[8], bu[8];
#pragma unroll
    for (int e = 0; e < 8; ++e) { bg[e] = p.ffn_conv_b[c8 + e]; bu[e] = p.ffn_conv_b[DFF + c8 + e]; }
#pragma unroll
    for (int j = 0; j < 3; ++j)
#pragma unroll
        for (int e = 0; e < 8; ++e) { wg[j][e] = p.ffn_conv_w[(size_t)j * DFF2 + c8 + e]; wu[j][e] = p.ffn_conv_w[(size_t)j * DFF2 + DFF + c8 + e]; }
    auto ldrow = [&](int ml, u32x4& g, u32x4& u) {
        if (ml >= 0 && ml < MSLAB) { const bf16_t* row = us + (size_t)ml * DFF2; g = *(const u32x4*)(row + c8); u = *(const u32x4*)(row + DFF + c8); }
        else { g = (u32x4){0u, 0u, 0u, 0u}; u = g; }
    };
    u32x4 gp, up, gc, uc, gn, un, gn2, un2, gn3, un3, gn4, un4;
    ldrow(t_beg - 1, gp, up); ldrow(t_beg, gc, uc); ldrow(t_beg + 1, gn, un); ldrow(t_beg + 2, gn2, un2); ldrow(t_beg + 3, gn3, un3);
    for (int ml = t_beg; ml < t_end; ++ml) {
        ldrow(ml + 4, gn4, un4);
        int base, t, T; seq_of(m0 + ml, base, t, T);
        const float mp = t > 0 ? 1.f : 0.f, mn = t + 1 < T ? 1.f : 0.f;
        const unsigned gpa[4] = {gp.x, gp.y, gp.z, gp.w}, gca[4] = {gc.x, gc.y, gc.z, gc.w}, gna[4] = {gn.x, gn.y, gn.z, gn.w};
        const unsigned upa[4] = {up.x, up.y, up.z, up.w}, uca[4] = {uc.x, uc.y, uc.z, uc.w}, una[4] = {un.x, un.y, un.z, un.w};
        float r[8];
#pragma unroll
        for (int e = 0; e < 4; ++e) {
            const float g0 = bg[2 * e] + mp * bflo(gpa[e]) * wg[0][2 * e] + bflo(gca[e]) * wg[1][2 * e] + mn * bflo(gna[e]) * wg[2][2 * e];
            const float g1 = bg[2 * e + 1] + mp * bfhi(gpa[e]) * wg[0][2 * e + 1] + bfhi(gca[e]) * wg[1][2 * e + 1] + mn * bfhi(gna[e]) * wg[2][2 * e + 1];
            const float u0 = bu[2 * e] + mp * bflo(upa[e]) * wu[0][2 * e] + bflo(uca[e]) * wu[1][2 * e] + mn * bflo(una[e]) * wu[2][2 * e];
            const float u1 = bu[2 * e + 1] + mp * bfhi(upa[e]) * wu[0][2 * e + 1] + bfhi(uca[e]) * wu[1][2 * e + 1] + mn * bfhi(una[e]) * wu[2][2 * e + 1];
            r[2 * e] = silu_f(g0) * u0; r[2 * e + 1] = silu_f(g1) * u1;
        }
        *(u32x4*)(act + (size_t)ml * DFFP + c8) = (u32x4){cvtpk(r[0], r[1]), cvtpk(r[2], r[3]), cvtpk(r[4], r[5]), cvtpk(r[6], r[7])};
        gp = gc; up = uc; gc = gn; uc = un; gn = gn2; un = un2; gn2 = gn3; un2 = un3; gn3 = gn4; un3 = un4;
    }
}

constexpr int NPHASE = 14;
constexpr int Q_DNS = 16, Q_ATS = 512, Q_DNP = 256, Q_ATP = 1024, Q_TOTAL = Q_DNS + Q_ATS + Q_DNP + Q_ATP;

DI void run_phase(const Params& p, int ph, char* lds) {
    char* ws = p.ws;
    switch (ph) {
    case 0: phase0(p, lds); break;
    case 1: {
        FInProj f{(bf16_t*)((char*)p.out + 2 * U1), (bf16_t*)(ws + OFF_PROJD), (bf16_t*)(ws + OFF_Z), (float*)(ws + OFF_GATES)};
        run_gemm(lds, (const bf16_t*)p.out, (const bf16_t*)(ws + OFF_WIN), 1024, M_TOK / 256, INWP / 256, f);
    } break;
    case 2: {
        phase_attn_prep(p);
        {
            u32x2 xr[20];
#pragma unroll
            for (int r = 0; r < 20; ++r) xr[r] = (u32x2){0u, 0u};
            if ((int)blockIdx.x < NCHUNK * 4) dn_prep_load(p, blockIdx.x >> 2, blockIdx.x & 3, xr);
            for (int u = blockIdx.x; u < NCHUNK * 4; u += gridDim.x) {
                const int un = u + gridDim.x;
                dn_prep_unit(p, u >> 2, u & 3, lds, xr, un < NCHUNK * 4 ? (un >> 2) : -1, un & 3);
            }
        }
    } break;
    case 3: {
        unsigned* ctr = (unsigned*)(ws + OFF_CTR);
        int* item_s = (int*)(lds + LDS_BYTES - 16);
        const bf16_t* bufA = (const bf16_t*)((char*)p.out + 2 * U1);
        bf16_t* ao = (bf16_t*)(ws + OFF_MIX);
        for (;;) {
            __syncthreads();
            if (threadIdx.x == 0) *item_s = (int)atomicAdd(ctr, 1u);
            __syncthreads();
            const int it = __builtin_amdgcn_readfirstlane(*item_s);
            if (it >= Q_TOTAL) break;
#ifndef SKIP_SCAN
            if (it < Q_DNS) { const int sq = it >> 3; dn_scan_item(p, MP + sq * 16384, 16384, (it >> 1) & 3, it & 1, lds); }
#else
            if (it < Q_DNS) {}
#endif
            else if (it >= Q_DNS + Q_ATS && it < Q_DNS + Q_ATS + Q_DNP) {
#ifndef SKIP_SCAN
                const int u = it - Q_DNS - Q_ATS; dn_scan_item(p, (u >> 3) * 2048, 2048, (u >> 1) & 3, u & 1, lds);
#endif
            } else {
                size_t r0; int kvh, qb, seq;
                if (it < Q_DNS + Q_ATS) { const int u = it - Q_DNS, bk = u >> 7; qb = u & 127; kvh = bk & 1; r0 = (size_t)MP + (size_t)(bk >> 1) * 16384; seq = 16384; }
                else { const int u = it - Q_DNS - Q_ATS - Q_DNP, bk = u >> 4; qb = u & 15; kvh = bk & 1; r0 = (size_t)(bk >> 1) * 2048; seq = 2048; }
#ifndef SKIP_ATTN
                attn_unit(bufA + (r0 + qb * 128) * 1024 + kvh * 256, bufA + r0 * 1024 + 512 + kvh * 128, bufA + r0 * 1024 + 768 + kvh * 128,
                          ao + (r0 + qb * 128) * 1024 + kvh * 256, p.o_norm_w, seq, lds);
#endif
            }
        }
    } break;
    case 4: phase_dn_combine(p); break;
    case 5: {
        pg8::Gemm g{(const bf16_t*)(ws + OFF_MIX), (const bf16_t*)(ws + OFF_WOUT), M_TOK, 1024, 1024};
        pg8::XcdOrder S; S.init(M_TOK / 256, 4);
        EpiOutProj E{p.x_prompt, p.x_sample, p.out, (bf16_t*)(ws + OFF_H2), (float*)(ws + OFF_SS)};
        pg8::gemm_phase<EpiOutProj, pg8::XcdOrder, true, true>((PG8_LAS unsigned char*)lds, g, S, E);
    } break;
    case 6: break;
    case 7: case 10: {
        const int slab = ph == 7 ? 0 : 1;
        FU f{(bf16_t*)(ws + OFF_US), (const float*)(ws + OFF_SS) + (size_t)slab * MSLAB};
        run_gemm(lds, (const bf16_t*)(ws + OFF_H2) + (size_t)slab * MSLAB * 1024, (const bf16_t*)(ws + OFF_WFFI), 1024, MSLAB / 256, DFF2P / 256, f);
    } break;
    case 8: case 11: phase_ffn_act(p, ph == 8 ? 0 : 1); break;
    case 9: case 12: {
        const int slab = ph == 9 ? 0 : 1;
        FResOut f{p.out + (size_t)slab * MSLAB * DM};
        run_gemm(lds, (const bf16_t*)(ws + OFF_ACT), (const bf16_t*)(ws + OFF_WFFO), DFFP, MSLAB / 256, 4, f);
    } break;
    default: break;
    }
}

DI void grid_bar(unsigned* ctr, unsigned target) {
    asm volatile("s_waitcnt vmcnt(0)" ::: "memory");
    __syncthreads();
    if (threadIdx.x == 0) {
        __builtin_amdgcn_fence(__ATOMIC_RELEASE, "agent");
        asm volatile("s_waitcnt vmcnt(0)" ::: "memory");
        __hip_atomic_fetch_add(ctr, 1u, __ATOMIC_RELAXED, __HIP_MEMORY_SCOPE_AGENT);
        while (__hip_atomic_load(ctr, __ATOMIC_RELAXED, __HIP_MEMORY_SCOPE_AGENT) < target) __builtin_amdgcn_s_sleep(4);
        __builtin_amdgcn_fence(__ATOMIC_ACQUIRE, "agent");
        asm volatile("s_waitcnt vmcnt(0)" ::: "memory");
    }
    __syncthreads();
}

__global__ void __launch_bounds__(NTHR) mega(Params p, int ph0, int ph1) {
    extern __shared__ __attribute__((aligned(16))) char lds[];
    cg::grid_group grid = cg::this_grid();
#ifdef ONLY_PH
    run_phase(p, ONLY_PH, lds);
#else
    unsigned* bar = (unsigned*)(p.ws + OFF_CTR + 1024);
    run_phase(p, 0, lds); grid.sync();
    run_phase(p, 1, lds); grid_bar(bar, 1u * gridDim.x);
    run_phase(p, 2, lds); grid_bar(bar, 2u * gridDim.x);
    run_phase(p, 3, lds); grid_bar(bar, 3u * gridDim.x);
    run_phase(p, 4, lds); grid_bar(bar, 4u * gridDim.x);
    run_phase(p, 5, lds); grid_bar(bar, 5u * gridDim.x);
    run_phase(p, 7, lds); grid_bar(bar, 6u * gridDim.x);
    run_phase(p, 8, lds); grid_bar(bar, 7u * gridDim.x);
    run_phase(p, 9, lds); grid_bar(bar, 8u * gridDim.x);
    run_phase(p, 10, lds); grid_bar(bar, 9u * gridDim.x);
    run_phase(p, 11, lds); grid_bar(bar, 10u * gridDim.x);
    run_phase(p, 12, lds);
#endif
}

extern "C" void kernel_launch(void* const* d_in, const int* in_sizes, int n_in, void* d_out, int out_size, void* d_ws, size_t ws_size, hipStream_t stream) {
    static int grid_blocks = 0;
    if (!grid_blocks) {
        hipFuncSetAttribute((const void*)mega, hipFuncAttributeMaxDynamicSharedMemorySize, LDS_BYTES);
        int dev = 0, cus = 0, per_cu = 0;
        hipGetDevice(&dev);
        hipDeviceGetAttribute(&cus, hipDeviceAttributeMultiprocessorCount, dev);
        hipOccupancyMaxActiveBlocksPerMultiprocessor(&per_cu, mega, NTHR, LDS_BYTES);
        if (per_cu < 1) per_cu = 1;
        grid_blocks = cus;
        if (grid_blocks % 8) grid_blocks -= grid_blocks % 8;
    }
    Params p{};
    p.x_prompt = (const float*)d_in[0]; p.x_sample = (const float*)d_in[1]; p.norm1_w = (const float*)d_in[2]; p.w_in = (const float*)d_in[3];
    p.dn_conv_w = (const float*)d_in[4]; p.A_log_f = (const float*)d_in[5]; p.A_log_b = (const float*)d_in[6]; p.dt_f = (const float*)d_in[7];
    p.dt_b = (const float*)d_in[8]; p.dn_norm_w = (const float*)d_in[9]; p.q_norm_w = (const float*)d_in[10]; p.k_norm_w = (const float*)d_in[11];
    p.o_norm_w = (const float*)d_in[12]; p.w_out = (const float*)d_in[13]; p.norm2_w = (const float*)d_in[14]; p.w_ffn_in = (const float*)d_in[15];
    p.ffn_conv_w = (const float*)d_in[16]; p.ffn_conv_b = (const float*)d_in[17]; p.w_ffn_out = (const float*)d_in[18];
    p.out = (float*)d_out; p.ws = (char*)d_ws;
    int ph0 = 0, ph1 = NPHASE - 1;
    void* args[] = {&p, &ph0, &ph1};
    hipError_t e = hipLaunchCooperativeKernel((void*)mega, dim3(grid_blocks), dim3(NTHR), args, LDS_BYTES, stream);
    if (e != hipSuccess) fprintf(stderr, "cooperative launch failed: %s (grid %d)\n", hipGetErrorString(e), grid_blocks);
}
```

```cpp
#include <hip/hip_runtime.h>
#include <hip/hip_cooperative_groups.h>
#include <cstdio>
#include <cstdint>
#include <utility>
namespace cg = cooperative_groups;

typedef unsigned short bf16_t;
typedef short bf16x8 __attribute__((ext_vector_type(8)));
typedef short s16x4 __attribute__((ext_vector_type(4)));
typedef float f32x16 __attribute__((ext_vector_type(16)));
typedef float f32x4 __attribute__((ext_vector_type(4)));
typedef float f32x2 __attribute__((ext_vector_type(2)));
typedef unsigned u32x4 __attribute__((ext_vector_type(4)));
typedef unsigned u32x2 __attribute__((ext_vector_type(2)));
typedef __bf16 bfv2 __attribute__((ext_vector_type(2)));
#define DI __device__ __forceinline__
#define MFMA32(a, b, c) __builtin_amdgcn_mfma_f32_32x32x16_bf16((a), (b), (c), 0, 0, 0)

constexpr int M_TOK = 98304, MP = 65536, DM = 1024;
constexpr int INW = 3088, INWP = 3328, DFF = 2752, DFF2 = 5504, DFF2P = 5632;
constexpr int NTHR = 512;
constexpr size_t U1 = (size_t)M_TOK * 512 * 2;
constexpr int LDS_BYTES = 163840;
constexpr int NCHUNK = M_TOK / 64;
constexpr int MSLAB = M_TOK / 2;
constexpr int DFFP = 2816;
constexpr size_t OFF_WIN = 0;
constexpr size_t OFF_WOUT = OFF_WIN + (size_t)INWP * 1024 * 2;
constexpr size_t OFF_WFFI = OFF_WOUT + (size_t)1024 * 1024 * 2;
constexpr size_t OFF_WFFO = OFF_WFFI + (size_t)DFF2P * 1024 * 2;
constexpr size_t OFF_ROPE = OFF_WFFO + (size_t)1024 * DFFP * 2;
constexpr size_t OFF_CTR = OFF_ROPE + 65536;
constexpr size_t OFF_GATES = OFF_CTR + 65536;
constexpr size_t OFF_Z = OFF_GATES + (size_t)M_TOK * 16 * 4;
constexpr size_t OFF_WC = OFF_Z + U1;
constexpr size_t OFF_UC = OFF_WC + 2 * U1;
constexpr size_t OFF_AC = OFF_UC + 2 * U1;
constexpr size_t OFF_GC = OFF_AC + U1;
constexpr size_t OFF_PROJD = OFF_GC + (size_t)NCHUNK * 8 * 64 * 4;
constexpr size_t OFF_MIX = OFF_PROJD, OFF_OF = OFF_PROJD + 2 * U1, OFF_OB = OFF_PROJD + 3 * U1;
constexpr size_t OFF_H2 = OFF_GATES;
constexpr size_t OFF_US = OFF_H2 + 2 * U1;
constexpr size_t OFF_ACT = OFF_US + (size_t)MSLAB * DFF2 * 2;
constexpr size_t OFF_SS = OFF_ACT + (size_t)MSLAB * DFFP * 2;
static_assert(OFF_SS >= OFF_PROJD + 4 * U1 && OFF_SS + (size_t)M_TOK * 4 <= 1073741824ull, "ws map");
static_assert(OFF_PROJD + 4 * U1 <= 1073741824ull, "ws map");
static_assert(OFF_ACT + (size_t)MSLAB * DFFP * 2 <= 1073741824ull, "ws map");
static_assert(OFF_WIN % 256 == 0 && OFF_GATES % 256 == 0 && OFF_PROJD % 256 == 0 && OFF_US % 256 == 0 && OFF_ACT % 256 == 0, "ws align");

struct Params {
    const float* x_prompt; const float* x_sample; const float* norm1_w; const float* w_in; const float* dn_conv_w;
    const float* A_log_f; const float* A_log_b; const float* dt_f; const float* dt_b; const float* dn_norm_w;
    const float* q_norm_w; const float* k_norm_w; const float* o_norm_w; const float* w_out; const float* norm2_w;
    const float* w_ffn_in; const float* ffn_conv_w; const float* ffn_conv_b; const float* w_ffn_out;
    float* out; char* ws;
};

DI float bf2f(bf16_t v) { return __uint_as_float(((unsigned)v) << 16); }
DI unsigned cvtpk(float lo, float hi) { f32x2 v = {lo, hi}; bfv2 r = __builtin_convertvector(v, bfv2); return __builtin_bit_cast(unsigned, r); }
DI bf16_t f2bf(float x) { return (bf16_t)(cvtpk(x, 0.f) & 0xffffu); }
DI float bflo(unsigned w) { return __uint_as_float(w << 16); }
DI float bfhi(unsigned w) { return __uint_as_float(w & 0xffff0000u); }
DI int crow(int r, int hi) { return (r & 3) + 8 * (r >> 2) + 4 * hi; }
DI float silu_f(float v) { return v * __builtin_amdgcn_rcpf(1.f + __expf(-v)); }
DI const float* xrow(const Params& p, int m) { return m < MP ? p.x_prompt + (size_t)m * DM : p.x_sample + (size_t)(m - MP) * DM; }
DI void seq_of(int m, int& base, int& t, int& T) { if (m < MP) { base = m & ~2047; t = m & 2047; T = 2048; } else { int r = m - MP; base = MP + (r & ~16383); t = r & 16383; T = 16384; } }
DI bf16x8 pack8(const f32x16& x, int s) {
    u32x4 w = {cvtpk(x[8 * s], x[8 * s + 1]), cvtpk(x[8 * s + 2], x[8 * s + 3]), cvtpk(x[8 * s + 4], x[8 * s + 5]), cvtpk(x[8 * s + 6], x[8 * s + 7])};
    return __builtin_bit_cast(bf16x8, w);
}
DI bf16x8 ld2x64(const char* p0, const char* p1) { u32x2 a = *(const u32x2*)p0, b = *(const u32x2*)p1; u32x4 w = {a.x, a.y, b.x, b.y}; return __builtin_bit_cast(bf16x8, w); }

DI void transpose_w(const float* in, int K, int N, bf16_t* out, int Kpad, int tile, char* lds, const float* kscale = nullptr) {
    float* tl = (float*)lds;
    const int nkt = Kpad / 64, tid = threadIdx.x;
    const int k0 = (tile % nkt) * 64, n0 = (tile / nkt) * 64;
    __syncthreads();
#pragma unroll
    for (int i = 0; i < 8; ++i) { int nl = tid & 63, kl = (tid >> 6) + 8 * i; int n = n0 + nl; float v = (n < N && k0 + kl < K) ? in[(size_t)(k0 + kl) * N + n] : 0.f; if (kscale) v *= kscale[k0 + kl]; tl[kl * 65 + nl] = v; }
    __syncthreads();
#pragma unroll
    for (int i = 0; i < 8; ++i) { int kl = tid & 63, nl = (tid >> 6) + 8 * i; out[(size_t)(n0 + nl) * Kpad + k0 + kl] = f2bf(tl[kl * 65 + nl]); }
}

DI void rmsnorm_rows(const Params& p, bool from_out, const float* w, bf16_t* dst) {
    const int wid = threadIdx.x >> 6, lane = threadIdx.x & 63;
    const int gw = blockIdx.x * 8 + wid, nw = gridDim.x * 8;
    f32x4 wv[4];
#pragma unroll
    for (int i = 0; i < 4; ++i) wv[i] = *(const f32x4*)(w + i * 256 + lane * 4);
    for (int m0 = gw; m0 < M_TOK; m0 += 2 * nw) {
        f32x4 v[2][4];
#pragma unroll
        for (int q = 0; q < 2; ++q) {
            const int m = min(m0 + q * nw, M_TOK - 1);
            const float* src = from_out ? (const float*)(p.out + (size_t)m * DM) : xrow(p, m);
#pragma unroll
            for (int i = 0; i < 4; ++i) v[q][i] = *(const f32x4*)(src + i * 256 + lane * 4);
        }
#pragma unroll
        for (int q = 0; q < 2; ++q) {
            const int m = m0 + q * nw;
            float ss = 0.f;
#pragma unroll
            for (int i = 0; i < 4; ++i) ss += v[q][i][0] * v[q][i][0] + v[q][i][1] * v[q][i][1] + v[q][i][2] * v[q][i][2] + v[q][i][3] * v[q][i][3];
#pragma unroll
            for (int o = 32; o >= 1; o >>= 1) ss += __shfl_xor(ss, o);
            const float rs = rsqrtf(ss * (1.f / 1024.f) + 1e-6f);
            if (m < M_TOK) {
#pragma unroll
                for (int i = 0; i < 4; ++i) {
                    u32x2 o2 = {cvtpk(v[q][i][0] * rs * wv[i][0], v[q][i][1] * rs * wv[i][1]), cvtpk(v[q][i][2] * rs * wv[i][2], v[q][i][3] * rs * wv[i][3])};
                    *(u32x2*)(dst + (size_t)m * DM + i * 256 + lane * 4) = o2;
                }
            }
        }
    }
}

__device__ const double kInvFreq[32] = {1.0, 0.7498942093324559, 0.5623413251903491, 0.4216965034285822, 0.31622776601683794, 0.23713737056616552, 0.1778279410038923, 0.1333521432163324, 0.1, 0.07498942093324558, 0.05623413251903491, 0.042169650342858224, 0.03162277660168379, 0.023713737056616554, 0.01778279410038923, 0.01333521432163324, 0.01, 0.007498942093324558, 0.005623413251903491, 0.004216965034285823, 0.0031622776601683794, 0.0023713737056616554, 0.0017782794100389228, 0.001333521432163324, 0.001, 0.0007498942093324559, 0.0005623413251903491, 0.00042169650342858224, 0.00031622776601683794, 0.00023713737056616554, 0.00017782794100389227, 0.0001333521432163324};

DI void phase0(const Params& p, char* lds) {
    char* ws = p.ws;
    const int nt0 = 16 * (INWP / 64), nt1 = 16 * 16, nt2 = 16 * (DFF2P / 64), nt3 = (DFFP / 64) * 16;
    for (int t = blockIdx.x; t < nt0 + nt1 + nt2 + nt3; t += gridDim.x) {
        if (t < nt0) transpose_w(p.w_in, 1024, INW, (bf16_t*)(ws + OFF_WIN), 1024, t, lds);
        else if (t < nt0 + nt1) transpose_w(p.w_out, 1024, 1024, (bf16_t*)(ws + OFF_WOUT), 1024, t - nt0, lds);
        else if (t < nt0 + nt1 + nt2) transpose_w(p.w_ffn_in, 1024, DFF2, (bf16_t*)(ws + OFF_WFFI), 1024, t - nt0 - nt1, lds, p.norm2_w);
        else transpose_w(p.w_ffn_out, DFF, 1024, (bf16_t*)(ws + OFF_WFFO), DFFP, t - nt0 - nt1 - nt2, lds);
    }
    if (blockIdx.x == 0 && threadIdx.x < 32) {
        const double w = kInvFreq[threadIdx.x], w2 = w * w;
        double sn = 0.0, cs = 0.0, ts = w, tc = 1.0;
        for (int k = 0; k < 12; ++k) { sn += ts; cs += tc; tc = -tc * w2 / ((2 * k + 1) * (2 * k + 2)); ts = -ts * w2 / ((2 * k + 2) * (2 * k + 3)); }
        double c = 1.0, s = 0.0; float* tab = (float*)(ws + OFF_ROPE);
        for (int pos = 0; pos < 256; ++pos) { tab[(pos * 32 + threadIdx.x) * 2] = (float)c; tab[(pos * 32 + threadIdx.x) * 2 + 1] = (float)s; double c2 = c * cs - s * sn, s2 = s * cs + c * sn; c = c2; s = s2; }
    }
    if (blockIdx.x == 0 && threadIdx.x == 64) { atomicExch((unsigned*)(ws + OFF_CTR), 0u); }
    for (int i = blockIdx.x * NTHR + threadIdx.x; i < M_TOK; i += gridDim.x * NTHR) ((float*)(ws + OFF_SS))[i] = 0.f;
    rmsnorm_rows(p, false, p.norm1_w, (bf16_t*)p.out);
}

namespace pg8 {
#define PG8_LAS __attribute__((address_space(3)))
constexpr int BM = 256, BK = 64, HALF = 128, HTB = HALF * BK * 2, STAGE_BYTES = 8 * HTB;
DI int lds_byte(int r, int c) { const int st = (r >> 4) * 2 + (c >> 5), rr = r & 15, cc = c & 31, ob = rr * 64 + cc * 2; return st * 1024 + (ob ^ (((ob >> 9) & 1) << 5)); }
DI void stage_rc(int b, int& R, int& C) { const int st = b / 1024, sb = b % 1024, swz = sb ^ (((sb >> 9) & 1) << 5); R = (st >> 1) * 16 + swz / 64; C = (st & 1) * 32 + (swz % 64) / 2; }
DI int perm32(int rho) { const int n = rho >> 4, i = rho & 15; return 8 * (i >> 2) + 4 * n + (i & 3); }
struct Unit { int pm, pn; };
struct Gemm { const bf16_t* A; const bf16_t* Bt; int M, N, K; };
struct XcdOrder {
    int nN, mpx, bpx, xcd, loc, total;
    DI void init(int mt_cnt, int nN_) { nN = nN_; mpx = mt_cnt / 8; bpx = gridDim.x / 8; xcd = blockIdx.x % 8; loc = blockIdx.x / 8; total = mpx * nN; }
    DI bool next(int i, Unit& u) const {
        const int j = loc + i * bpx; if (j >= total) return false;
        const int grp = j / (4 * nN), rem = j % (4 * nN);
        u.pm = xcd * mpx + grp * 4 + (rem & 3); u.pn = rem >> 2; return true;
    }
    DI void a_ready(const Unit&) const {}
    DI void done(const Unit&) const {}
};
template <class Epi, class Sched, bool ALIGN_EPI = false, bool SP2 = false>
__device__ __forceinline__ void gemm_phase(PG8_LAS unsigned char* lds, const Gemm g, const Sched& S, const Epi& E) {
    const int tid = threadIdx.x, wid = __builtin_amdgcn_readfirstlane(tid >> 6), lane = tid & 63, wr = wid >> 2, wc = wid & 3, fr = lane & 15, fq = lane >> 4;
    const int K = g.K, nt = K / BK;
    unsigned voffA[2], voffB[2];
#pragma unroll
    for (int i = 0; i < 2; ++i) { int R, C; stage_rc(tid * 16 + i * 8192, R, C); const int Rb = Epi::PERM ? ((R & ~31) + perm32(R & 31)) : R;
        voffA[i] = (unsigned)(R * K + C) * 2u; voffB[i] = (unsigned)(Rb * K + C) * 2u; }
    const size_t kstep = (size_t)(BK * 2);
    const size_t hstep = (size_t)HALF * K * 2;
    const size_t tstep = 2 * hstep;
    const unsigned ldsw = (unsigned)wid * 1024u;
    const int aoff = lds_byte(wr * 64 + fr, fq * 8), boff = lds_byte(wc * 32 + fr, fq * 8);
#define PG8_SA(b, h) (((b) * 2 + (h)) * HTB)
#define PG8_SB(b, h) ((4 + (b) * 2 + (h)) * HTB)
#define PG8_STAGE(bufoff, gbase, voff) do { _Pragma("unroll") for (int _i = 0; _i < 2; ++_i) \
        __builtin_amdgcn_global_load_lds((const unsigned*)((const char*)(gbase) + (voff)[_i]), (PG8_LAS unsigned*)(lds + (bufoff) + ldsw + _i * 8192), 16, 0, 0); } while (0)
#define PG8_LDA(dst, b, h) do { _Pragma("unroll") for (int m = 0; m < 4; ++m) _Pragma("unroll") for (int k = 0; k < 2; ++k) dst[m][k] = *(const PG8_LAS bf16x8*)(lds + PG8_SA(b, h) + aoff + m * 2048 + k * 1024); } while (0)
#define PG8_LDB(dst, b, h) do { _Pragma("unroll") for (int n = 0; n < 2; ++n) _Pragma("unroll") for (int k = 0; k < 2; ++k) dst[n][k] = *(const PG8_LAS bf16x8*)(lds + PG8_SB(b, h) + boff + n * 2048 + k * 1024); } while (0)
#define PG8_MMA(ai, bj, At, Bt) do { __builtin_amdgcn_s_setprio(1); _Pragma("unroll") for (int m = 0; m < 4; ++m) _Pragma("unroll") for (int n = 0; n < 2; ++n) _Pragma("unroll") for (int k = 0; k < 2; ++k) \
        acc[ai][bj][m][n] = __builtin_amdgcn_mfma_f32_16x16x32_bf16(Bt[n][k], At[m][k], acc[ai][bj][m][n], 0, 0, 0); __builtin_amdgcn_s_setprio(0); } while (0)
#define PG8_WAIT_V(n) asm volatile("s_waitcnt vmcnt(" #n ")" ::: "memory")
#define PG8_WAIT_L(n) asm volatile("s_waitcnt lgkmcnt(" #n ")" ::: "memory")
#define PG8_BAR __builtin_amdgcn_s_barrier()
#define PG8_SCHED __builtin_amdgcn_sched_barrier(0)
    Unit cur, nxt; int ui = 0;
    if (!S.next(0, cur)) return;
    f32x4 acc[2][2][4][2];
#pragma unroll
    for (int a = 0; a < 2; ++a)
#pragma unroll
        for (int b = 0; b < 2; ++b)
#pragma unroll
            for (int m = 0; m < 4; ++m)
#pragma unroll
                for (int n = 0; n < 2; ++n) acc[a][b][m][n] = (f32x4){0.f, 0.f, 0.f, 0.f};
    bf16x8 At[4][2], B0[2][2], B1[2][2];
    const char* cA = (const char*)g.A + (size_t)cur.pm * tstep; const char* cB = (const char*)g.Bt + (size_t)cur.pn * tstep;
    S.a_ready(cur);
    if constexpr (SP2) {
        PG8_STAGE(PG8_SB(0, 0), cB, voffB); PG8_STAGE(PG8_SB(0, 1), cB + hstep, voffB); PG8_STAGE(PG8_SA(0, 0), cA, voffA); PG8_STAGE(PG8_SA(0, 1), cA + hstep, voffA);
        if (wr == 1) PG8_BAR;
        PG8_WAIT_V(2); PG8_BAR;
        PG8_STAGE(PG8_SB(1, 0), cB + kstep, voffB); PG8_STAGE(PG8_SA(1, 0), cA + kstep, voffA); PG8_STAGE(PG8_SB(1, 1), cB + hstep + kstep, voffB);
        PG8_WAIT_V(6); PG8_BAR;
    } else {
        PG8_STAGE(PG8_SB(0, 0), cB, voffB); PG8_STAGE(PG8_SA(0, 0), cA, voffA); PG8_STAGE(PG8_SB(0, 1), cB + hstep, voffB); PG8_STAGE(PG8_SA(0, 1), cA + hstep, voffA);
        if (wr == 1) PG8_BAR;
        PG8_WAIT_V(4); PG8_BAR;
        PG8_STAGE(PG8_SB(1, 0), cB + kstep, voffB); PG8_STAGE(PG8_SA(1, 0), cA + kstep, voffA); PG8_STAGE(PG8_SB(1, 1), cB + hstep + kstep, voffB);
        PG8_WAIT_V(6); PG8_BAR;
    }
    for (;;) {
        const bool has_next = S.next(ui + 1, nxt);
        const char* nA = has_next ? (const char*)g.A + (size_t)nxt.pm * tstep : cA; const char* nB = has_next ? (const char*)g.Bt + (size_t)nxt.pn * tstep : cB;
        for (int t = 0; t < nt; t += 2) {
            const bool last = (t == nt - 2);
            const char* a1 = cA + (size_t)(t + 1) * kstep;
            const char* a2 = last ? nA : cA + (size_t)(t + 2) * kstep; const char* b2 = last ? nB : cB + (size_t)(t + 2) * kstep;
            const char* a3 = a2 + kstep; const char* b3 = b2 + kstep;
            if (last && has_next) S.a_ready(nxt);
            if constexpr (SP2) {
            PG8_LDB(B0, 0, 0); PG8_LDB(B1, 0, 1); PG8_SCHED; PG8_LDA(At, 0, 0); PG8_STAGE(PG8_SA(1, 1), a1 + hstep, voffA);
            PG8_WAIT_V(8); PG8_WAIT_L(0); PG8_BAR; PG8_MMA(0, 0, At, B0); PG8_MMA(0, 1, At, B1); PG8_BAR; PG8_SCHED;
            PG8_LDA(At, 0, 1); PG8_STAGE(PG8_SB(0, 0), b2, voffB); PG8_STAGE(PG8_SB(0, 1), b2 + hstep, voffB); PG8_STAGE(PG8_SA(0, 0), a2, voffA);
            PG8_WAIT_V(8); PG8_WAIT_L(0); PG8_BAR; PG8_MMA(1, 0, At, B0); PG8_MMA(1, 1, At, B1); PG8_BAR; PG8_SCHED;
            PG8_LDB(B0, 1, 0); PG8_LDB(B1, 1, 1); PG8_SCHED; PG8_LDA(At, 1, 0); PG8_STAGE(PG8_SA(0, 1), a2 + hstep, voffA);
            PG8_WAIT_V(8); PG8_WAIT_L(0); PG8_BAR; PG8_MMA(0, 0, At, B0); PG8_MMA(0, 1, At, B1); PG8_BAR; PG8_SCHED;
            PG8_LDA(At, 1, 1); PG8_STAGE(PG8_SB(1, 0), b3, voffB); PG8_STAGE(PG8_SB(1, 1), b3 + hstep, voffB); PG8_STAGE(PG8_SA(1, 0), a3, voffA);
            PG8_WAIT_V(8); PG8_WAIT_L(0); PG8_BAR; PG8_MMA(1, 0, At, B0); PG8_MMA(1, 1, At, B1); PG8_BAR; PG8_SCHED;
            } else {
            PG8_LDB(B0, 0, 0); PG8_SCHED; PG8_LDA(At, 0, 0); PG8_STAGE(PG8_SA(1, 1), a1 + hstep, voffA);
            PG8_WAIT_L(8); PG8_BAR; PG8_WAIT_L(0); PG8_MMA(0, 0, At, B0); PG8_BAR; PG8_SCHED;
            PG8_LDB(B1, 0, 1); PG8_STAGE(PG8_SB(0, 0), b2, voffB);
            PG8_BAR; PG8_WAIT_L(0); PG8_MMA(0, 1, At, B1); PG8_BAR;
            PG8_LDA(At, 0, 1); PG8_STAGE(PG8_SA(0, 0), a2, voffA);
            PG8_BAR; PG8_WAIT_L(0); PG8_MMA(1, 0, At, B0); PG8_BAR; PG8_SCHED;
            PG8_STAGE(PG8_SB(0, 1), b2 + hstep, voffB);
            PG8_WAIT_V(6); PG8_BAR; PG8_MMA(1, 1, At, B1); PG8_BAR;
            PG8_LDB(B0, 1, 0); PG8_SCHED; PG8_LDA(At, 1, 0); PG8_STAGE(PG8_SA(0, 1), a2 + hstep, voffA);
            PG8_WAIT_L(8); PG8_BAR; PG8_WAIT_L(0); PG8_MMA(0, 0, At, B0); PG8_BAR; PG8_SCHED;
            PG8_LDB(B1, 1, 1); PG8_STAGE(PG8_SB(1, 0), b3, voffB);
            PG8_BAR; PG8_WAIT_L(0); PG8_MMA(0, 1, At, B1); PG8_BAR;
            PG8_LDA(At, 1, 1); PG8_STAGE(PG8_SA(1, 0), a3, voffA);
            PG8_BAR; PG8_WAIT_L(0); PG8_MMA(1, 0, At, B0); PG8_BAR; PG8_SCHED;
            PG8_STAGE(PG8_SB(1, 1), b3 + hstep, voffB);
            PG8_WAIT_V(6); PG8_BAR; PG8_MMA(1, 1, At, B1); PG8_BAR;
            }
        }
        if constexpr (ALIGN_EPI) { if (wr == 0) PG8_BAR; }
        if constexpr (!Epi::AFTER_DRAIN) { E(acc, cur, wr, wc, fr, fq); S.done(cur); }
        if (!has_next) break;
#pragma unroll
        for (int a = 0; a < 2; ++a)
#pragma unroll
            for (int b = 0; b < 2; ++b)
#pragma unroll
                for (int m = 0; m < 4; ++m)
#pragma unroll
                    for (int n = 0; n < 2; ++n) acc[a][b][m][n] = (f32x4){0.f, 0.f, 0.f, 0.f};
        cur = nxt; cA = nA; cB = nB; ++ui;
        if constexpr (ALIGN_EPI) { if (wr == 1) PG8_BAR; }
    }
    PG8_WAIT_V(0);
    if constexpr (!ALIGN_EPI) { if (wr == 0) PG8_BAR; }
    PG8_BAR;
    if constexpr (Epi::AFTER_DRAIN) { E.fused(acc, cur, wr, wc, fr, fq, lds, wid, lane); S.done(cur); }
#undef PG8_SA
#undef PG8_SB
#undef PG8_STAGE
#undef PG8_LDA
#undef PG8_LDB
#undef PG8_MMA
#undef PG8_WAIT_V
#undef PG8_WAIT_L
#undef PG8_BAR
#undef PG8_SCHED
}

template <class F> struct EpiRows {
    static constexpr bool PERM = true, AFTER_DRAIN = false;
    F f;
    DI void operator()(const f32x4 (&acc)[2][2][4][2], const Unit& u, int wr, int wc, int fr, int fq) const {
#pragma unroll
        for (int ai = 0; ai < 2; ++ai)
#pragma unroll
            for (int m = 0; m < 4; ++m) {
                const int r = u.pm * BM + ai * HALF + wr * 64 + m * 16 + fr;
#pragma unroll
                for (int bj = 0; bj < 2; ++bj) f(r, u.pn * BM + bj * HALF + wc * 32 + 8 * fq, acc[ai][bj][m][0], acc[ai][bj][m][1]);
                asm volatile("" ::: "memory");
            }
    }
};
}

DI void st_bf8(bf16_t* p, f32x4 a, f32x4 b) { u32x4 o = {cvtpk(a[0], a[1]), cvtpk(a[2], a[3]), cvtpk(b[0], b[1]), cvtpk(b[2], b[3])}; *(u32x4*)p = o; }

struct FInProj { bf16_t* bufA; bf16_t* projD; bf16_t* bufZ; float* gates;
    DI void operator()(int m, int n0, f32x4 a, f32x4 b) const {
        if (n0 < 1024) st_bf8(bufA + (size_t)m * 1024 + n0, a, b);
        else if (n0 < 2560) st_bf8(projD + (size_t)m * 1536 + (n0 - 1024), a, b);
        else if (n0 < 3072) st_bf8(bufZ + (size_t)m * 512 + (n0 - 2560), a, b);
        else if (n0 < 3088) { float* g = gates + (size_t)m * 16 + (n0 - 3072); *(f32x4*)g = a; *(f32x4*)(g + 4) = b; }
    } };
struct FResX { const float* xp; const float* xs; float* out;
    DI void operator()(int m, int n0, f32x4 a, f32x4 b) const {
        const float* xr = (m < MP ? xp + (size_t)m * DM : xs + (size_t)(m - MP) * DM) + n0;
        const f32x4 r0 = *(const f32x4*)xr, r1 = *(const f32x4*)(xr + 4);
        float* o = out + (size_t)m * DM + n0; *(f32x4*)o = r0 + a; *(f32x4*)(o + 4) = r1 + b;
    } };
struct FU { bf16_t* us; const float* ss;
    DI void operator()(int m, int n0, f32x4 a, f32x4 b) const { if (n0 < DFF2) { const float rs = rsqrtf(ss[m] * (1.f / 1024.f) + 1e-6f); st_bf8(us + (size_t)m * DFF2 + n0, a * rs, b * rs); } } };
struct FResOut { float* out;
    DI void operator()(int m, int n0, f32x4 a, f32x4 b) const { float* o = out + (size_t)m * DM + n0; const f32x4 r0 = *(const f32x4*)o, r1 = *(const f32x4*)(o + 4); *(f32x4*)o = r0 + a; *(f32x4*)(o + 4) = r1 + b; } };

struct EpiOutProj {
    static constexpr bool PERM = true, AFTER_DRAIN = false;
    const float* xp; const float* xs; float* out; bf16_t* xb; float* ss;
    DI void operator()(const f32x4 (&acc)[2][2][4][2], const pg8::Unit& u, int wr, int wc, int fr, int fq) const {
#pragma unroll
        for (int ai = 0; ai < 2; ++ai)
#pragma unroll
            for (int m = 0; m < 4; ++m) {
                const int r = u.pm * 256 + ai * 128 + wr * 64 + m * 16 + fr;
                const float* xr = (r < MP ? xp + (size_t)r * DM : xs + (size_t)(r - MP) * DM);
                float part = 0.f;
#pragma unroll
                for (int bj = 0; bj < 2; ++bj) {
                    const int n0 = u.pn * 256 + bj * 128 + wc * 32 + 8 * fq;
                    const f32x4 v0 = *(const f32x4*)(xr + n0) + acc[ai][bj][m][0], v1 = *(const f32x4*)(xr + n0 + 4) + acc[ai][bj][m][1];
                    float* o = out + (size_t)r * DM + n0; *(f32x4*)o = v0; *(f32x4*)(o + 4) = v1;
                    st_bf8(xb + (size_t)r * DM + n0, v0, v1);
                    part += (v0[0] * v0[0] + v0[1] * v0[1]) + (v0[2] * v0[2] + v0[3] * v0[3]) + (v1[0] * v1[0] + v1[1] * v1[1]) + (v1[2] * v1[2] + v1[3] * v1[3]);
                }
                part += __shfl_xor(part, 16); part += __shfl_xor(part, 32);
                if (fq == 0) atomicAdd(ss + r, part);
                asm volatile("" ::: "memory");
            }
    }
};

template <class F> DI void run_gemm(char* lds, const bf16_t* A, const bf16_t* Bt, int K, int mt_cnt, int nN, const F& f) {
    pg8::Gemm g{A, Bt, mt_cnt * 256, nN * 256, K};
    pg8::XcdOrder S; S.init(mt_cnt, nN);
    pg8::EpiRows<F> E{f};
    pg8::gemm_phase<pg8::EpiRows<F>, pg8::XcdOrder, true, true>((PG8_LAS unsigned char*)lds, g, S, E);
}

constexpr float ASCALE = 0.088388347648318440f;
constexpr float ATHR2 = 8.f * 1.4426950408889634f;
DI void phase_attn_prep(const Params& p) {
    bf16_t* bufA = (bf16_t*)((char*)p.out + 2 * U1);
    const float* tab = (const float*)(p.ws + OFF_ROPE);
    const int j = threadIdx.x & 7;
    const int gid = (blockIdx.x * NTHR + threadIdx.x) >> 3, ng = (gridDim.x * NTHR) >> 3;
    float wq[16], wk[16];
#pragma unroll
    for (int qd_ = 0; qd_ < 4; ++qd_)
#pragma unroll
        for (int e = 0; e < 4; ++e) { wq[qd_ * 4 + e] = p.q_norm_w[qd_ * 32 + 4 * j + e]; wk[qd_ * 4 + e] = p.k_norm_w[qd_ * 32 + 4 * j + e]; }
    for (int u0 = gid; u0 < M_TOK * 6; u0 += 2 * ng) {
        u32x2 raw[2][4]; bool ok[2];
#pragma unroll
        for (int q = 0; q < 2; ++q) {
            const int u = u0 + q * ng; ok[q] = u < M_TOK * 6;
            const int uu = ok[q] ? u : 0; const int m = uu / 6, slot = uu - m * 6;
            const bf16_t* ptr = bufA + (size_t)m * 1024 + slot * 128 + 4 * j;
#pragma unroll
            for (int qd_ = 0; qd_ < 4; ++qd_) raw[q][qd_] = *(const u32x2*)(ptr + 32 * qd_);
        }
#pragma unroll
        for (int q = 0; q < 2; ++q) {
            const int u = u0 + q * ng; const int uu = ok[q] ? u : 0; const int m = uu / 6, slot = uu - m * 6;
            int base, t, T; seq_of(m, base, t, T);
            float v[16]; float ss = 0.f;
#pragma unroll
            for (int qd_ = 0; qd_ < 4; ++qd_) { v[qd_ * 4] = bflo(raw[q][qd_].x); v[qd_ * 4 + 1] = bfhi(raw[q][qd_].x); v[qd_ * 4 + 2] = bflo(raw[q][qd_].y); v[qd_ * 4 + 3] = bfhi(raw[q][qd_].y); }
#pragma unroll
            for (int e = 0; e < 16; ++e) ss += v[e] * v[e];
#pragma unroll
            for (int o = 4; o >= 1; o >>= 1) ss += __shfl_xor(ss, o);
            const float rs = rsqrtf(ss * (1.f / 128.f) + 1e-6f);
            const float rsq = slot < 4 ? rs * (ASCALE * 1.4426950408889634f) : rs;
#pragma unroll
            for (int e = 0; e < 16; ++e) v[e] = v[e] * rsq * (slot < 4 ? wq[e] : wk[e]);
            const int pr = t >> 6, pc = t & 63;
            const f32x4* tr = (const f32x4*)(tab + (pr * 32 + 4 * j) * 2); const f32x4* tc = (const f32x4*)(tab + (pc * 32 + 4 * j) * 2);
            const f32x4 r0 = tr[0], r1 = tr[1], c0 = tc[0], c1 = tc[1];
            const float cr[4] = {r0[0], r0[2], r1[0], r1[2]}, sr[4] = {r0[1], r0[3], r1[1], r1[3]};
            const float cc[4] = {c0[0], c0[2], c1[0], c1[2]}, sc[4] = {c0[1], c0[3], c1[1], c1[3]};
            float o[16];
#pragma unroll
            for (int e = 0; e < 4; ++e) {
                o[e] = v[e] * cr[e] - v[4 + e] * sr[e]; o[4 + e] = v[4 + e] * cr[e] + v[e] * sr[e];
                o[8 + e] = v[8 + e] * cc[e] - v[12 + e] * sc[e]; o[12 + e] = v[12 + e] * cc[e] + v[8 + e] * sc[e];
            }
            if (ok[q]) {
                bf16_t* ptr = bufA + (size_t)m * 1024 + slot * 128 + 4 * j;
#pragma unroll
                for (int qd_ = 0; qd_ < 4; ++qd_) *(u32x2*)(ptr + 32 * qd_) = (u32x2){cvtpk(o[qd_ * 4], o[qd_ * 4 + 1]), cvtpk(o[qd_ * 4 + 2], o[qd_ * 4 + 3])};
            }
        }
    }
}

constexpr int PL_QB = 0, PL_KB = 16896, PL_VT = 33792, PL_KT = 52224, PL_GKK = 70656, PL_LF = 70656, PL_GQK = 87040, PL_LB = 103424, PL_T = 119808, PL_SM = 156672;

template <int PI> DI void tsolve_row(float (&x)[64], const float* L, int j, f32x4 (&lc)[8], f32x4 (&ln)[8]) {
    f32x4 lh[8];
#pragma unroll
    for (int s4 = 8; s4 < (PI + 3) / 4; ++s4) lh[s4 - 8] = *(const f32x4*)(L + PI * 64 + 4 * s4);
    if (PI + 1 < 64) {
#pragma unroll
        for (int s4 = 0; s4 < (PI + 4) / 4 && s4 < 8; ++s4) ln[s4] = *(const f32x4*)(L + (PI + 1) * 64 + 4 * s4);
    }
    asm volatile("" ::: "memory");
    float a[4] = {(PI == j) ? 1.f : 0.f, 0.f, 0.f, 0.f};
#pragma unroll
    for (int s4 = 0; s4 < (PI + 3) / 4 && s4 < 8; ++s4) {
#pragma unroll
        for (int k = 0; k < 4; ++k) if (4 * s4 + k < PI) a[k] -= lc[s4][k] * x[4 * s4 + k];
    }
#pragma unroll
    for (int s4 = 8; s4 < (PI + 3) / 4; ++s4) {
#pragma unroll
        for (int k = 0; k < 4; ++k) if (4 * s4 + k < PI) a[k] -= lh[s4 - 8][k] * x[4 * s4 + k];
    }
    x[PI] = (a[0] + a[1]) + (a[2] + a[3]);
}
template <int PI> DI void tsolve_pair(float (&x)[64], const float* L, int j, f32x4 (&la)[8], f32x4 (&lb)[8]) {
    tsolve_row<2 * PI>(x, L, j, la, lb);
    tsolve_row<2 * PI + 1>(x, L, j, lb, la);
}
template <int... Is> DI void tsolve_all(float (&x)[64], const float* L, int j, std::integer_sequence<int, Is...>) {
    f32x4 la[8], lb[8];
    (tsolve_pair<Is>(x, L, j, la, lb), ...);
}
template <int... Is> DI void tstore_all(const float (&x)[64], char* TU, char* TW, float mu, float mw, std::integer_sequence<int, Is...>) {
    ((*(bf16_t*)(TU + Is * 144) = f2bf(x[Is] * mu), *(bf16_t*)(TW + Is * 144) = f2bf(x[Is] * mw)), ...);
}

DI void dn_prep_load(const Params& p, int gchunk, int h, u32x2 (&xr)[20]) {
    int tid = threadIdx.x; asm volatile("" : "+v"(tid));
    if (tid < 384) {
        const bf16_t* projD = (const bf16_t*)(p.ws + OFF_PROJD);
        const int c4 = tid & 31, grp = tid >> 5, seg = grp >> 2, tq = grp & 3;
        const int ch = seg * 512 + h * 128 + c4 * 4;
        int base, t0, T; seq_of(gchunk * 64, base, t0, T);
#pragma unroll
        for (int r = 0; r < 20; ++r) {
            const int t = t0 + tq * 16 + r - 2;
            if (t >= 0 && t < T) xr[r] = *(const u32x2*)(projD + (size_t)(base + t) * 1536 + ch);
            else xr[r] = (u32x2){0u, 0u};
        }
    }
}

DI void dn_prep_unit(const Params& p, int gchunk, int h, char* lds, u32x2 (&xr)[20], int gchunk_n, int h_n) {
    int tid_ = threadIdx.x; asm volatile("" : "+v"(tid_));
    const int tid = tid_, wid = tid >> 6, lane = tid & 63, r32 = lane & 31, hh = lane >> 5;
    char* ws = p.ws;
    const float* gates = (const float*)(ws + OFF_GATES);
    bf16_t* qd = (bf16_t*)p.out; bf16_t* kd = (bf16_t*)((char*)p.out + U1);
    const int m0 = gchunk * 64;
    int base, t0, T; seq_of(m0, base, t0, T);
    float* Gkk = (float*)(lds + PL_GKK); float* Gqk = (float*)(lds + PL_GQK);
    float* sm = (float*)(lds + PL_SM);
    __syncthreads();
#ifndef SKIP_CONV
    if (tid < 384) {
        const int c4 = tid & 31, grp = tid >> 5, seg = grp >> 2, tq = grp & 3;
        const int ch = seg * 512 + h * 128 + c4 * 4;
        f32x4 w[5];
#pragma unroll
        for (int j = 0; j < 5; ++j) w[j] = *(const f32x4*)(p.dn_conv_w + j * 1536 + ch);
        f32x4 x[20];
#pragma unroll
        for (int r = 0; r < 20; ++r) x[r] = (f32x4){bflo(xr[r].x), bfhi(xr[r].x), bflo(xr[r].y), bfhi(xr[r].y)};
        unsigned tp[4][8];
#pragma unroll
        for (int i = 0; i < 16; i += 2) {
            f32x4 yy[2];
#pragma unroll
            for (int ii = 0; ii < 2; ++ii) {
                f32x4 a = x[i + ii] * w[0];
#pragma unroll
                for (int j = 1; j < 5; ++j) a += x[i + ii + j] * w[j];
                f32x4 y = {silu_f(a[0]), silu_f(a[1]), silu_f(a[2]), silu_f(a[3])};
                const int tl = tq * 16 + i + ii;
                if (seg < 2) {
                    float ss = y[0] * y[0] + y[1] * y[1] + y[2] * y[2] + y[3] * y[3];
#pragma unroll
                    for (int o = 16; o >= 1; o >>= 1) ss += __shfl_xor(ss, o);
                    float sc = rsqrtf(ss + 1e-6f); if (seg == 0) sc *= 0.08838834764831845f;
                    y = y * sc;
                    u32x2 o2 = {cvtpk(y[0], y[1]), cvtpk(y[2], y[3])};
                    *(u32x2*)(lds + (seg == 0 ? PL_QB : PL_KB) + tl * 264 + c4 * 8) = o2;
                    *(u32x2*)((seg == 0 ? qd : kd) + (size_t)(m0 + tl) * 512 + h * 128 + c4 * 4) = o2;
                }
                yy[ii] = y;
            }
#pragma unroll
            for (int e = 0; e < 4; ++e) tp[e][i >> 1] = cvtpk(yy[0][e], yy[1][e]);
        }
        if (seg >= 1) {
            char* dstT = lds + (seg == 1 ? PL_KT : PL_VT);
#pragma unroll
            for (int e = 0; e < 4; ++e) {
                char* d = dstT + (c4 * 4 + e) * 144 + tq * 32;
                *(u32x4*)d = (u32x4){tp[e][0], tp[e][1], tp[e][2], tp[e][3]};
                *(u32x4*)(d + 16) = (u32x4){tp[e][4], tp[e][5], tp[e][6], tp[e][7]};
            }
        }
    } else
#endif
    if (tid >= 384 && tid < 512) {
        const int dir = wid - 6, pidx = lane, tl = dir ? 63 - pidx : pidx;
        const float a = gates[(size_t)(m0 + tl) * 16 + dir * 4 + h], b = gates[(size_t)(m0 + tl) * 16 + 8 + dir * 4 + h];
        const float Al = dir ? p.A_log_b[h] : p.A_log_f[h], db = dir ? p.dt_b[h] : p.dt_f[h];
        const float xx = a + db; const float sp = xx > 20.f ? xx : log1pf(expf(xx));
        float g = -expf(Al) * sp; const float beta = 1.f / (1.f + expf(-b));
#pragma unroll
        for (int o = 1; o < 64; o <<= 1) { float n = __shfl_up(g, o); if (lane >= o) g += n; }
        sm[dir * 64 + pidx] = beta; sm[128 + dir * 64 + pidx] = g; sm[256 + dir * 64 + pidx] = beta; sm[384 + dir * 64 + pidx] = beta * __expf(g);
        ((float*)(ws + OFF_GC))[((size_t)(gchunk * 4 + h) * 2 + dir) * 64 + pidx] = g;
    }
    __syncthreads();
    if (gchunk_n >= 0) dn_prep_load(p, gchunk_n, h_n, xr);
    {
        const int mat = wid >> 2, ti = (wid >> 1) & 1, tj = wid & 1;
        const char* X = lds + (mat ? PL_QB : PL_KB); const char* Kb = lds + PL_KB;
        f32x16 acc;
#pragma unroll
        for (int i = 0; i < 16; ++i) acc[i] = 0.f;
#pragma unroll
        for (int ks = 0; ks < 8; ++ks) {
            const int off = (ks * 16 + hh * 8) * 2;
            bf16x8 a = ld2x64(X + (ti * 32 + r32) * 264 + off, X + (ti * 32 + r32) * 264 + off + 8);
            bf16x8 b = ld2x64(Kb + (tj * 32 + r32) * 264 + off, Kb + (tj * 32 + r32) * 264 + off + 8);
            acc = MFMA32(a, b, acc);
        }
        float* G = mat ? Gqk : Gkk;
#pragma unroll
        for (int i = 0; i < 16; ++i) G[(ti * 32 + crow(i, hh)) * 64 + tj * 32 + r32] = acc[i];
    }
    __syncthreads();
    {
        const int dir = tid >> 8, q = tid & 255, si = q & 63, p0 = (q >> 6) * 16;
        const float* beta = sm + dir * 64; const float* gc = sm + 128 + dir * 64;
        float* L = (float*)(lds + (dir ? PL_LB : PL_LF));
        bf16_t* Ac = (bf16_t*)(ws + OFF_AC) + ((size_t)(gchunk * 4 + h) * 2 + dir) * 4096;
        const int sx = dir ? 63 - si : si; const float gs = gc[si];
        float gk[16], gq[16];
#pragma unroll
        for (int k = 0; k < 16; ++k) { const int pi = p0 + k, c = dir ? 63 - pi : pi; gk[k] = Gkk[c * 64 + sx]; gq[k] = Gqk[c * 64 + sx]; }
        __syncthreads();
#pragma unroll
        for (int k = 0; k < 16; ++k) {
            const int pi = p0 + k;
            const float dec = (si <= pi) ? __expf(gc[pi] - gs) : 0.f;
            L[pi * 64 + si] = (si < pi) ? beta[pi] * gk[k] * dec : 0.f;
            Ac[pi * 64 + si] = f2bf(gq[k] * dec);
        }
    }
    __syncthreads();
    if (tid < 128) {
        const int dir = tid >> 6, j = tid & 63;
        const float* L = (const float*)(lds + (dir ? PL_LB : PL_LF));
        float x[64];
        tsolve_all(x, L, j, std::make_integer_sequence<int, 32>{});
        const int kpos = dir ? 63 - j : j;
        char* TU = lds + PL_T + (dir * 2) * 9216 + kpos * 2; char* TW = TU + 9216;
        tstore_all(x, TU, TW, sm[256 + dir * 64 + j], sm[384 + dir * 64 + j], std::make_integer_sequence<int, 64>{});
    }
    __syncthreads();
    {
        const int dir = wid >> 2, which = (wid >> 1) & 1, half = wid & 1;
        const char* Ta = lds + PL_T + (dir * 2 + which) * 9216;
        const char* Bm = lds + (which ? PL_KT : PL_VT);
        const size_t ci = (size_t)(gchunk * 4 + h) * 2 + dir;
        f32x16 acc[2][2];
#pragma unroll
        for (int a = 0; a < 2; ++a)
#pragma unroll
            for (int b = 0; b < 2; ++b)
#pragma unroll
                for (int i = 0; i < 16; ++i) acc[a][b][i] = 0.f;
#pragma unroll
        for (int ks = 0; ks < 4; ++ks) {
            const int ko = (ks * 16 + hh * 8) * 2;
            bf16x8 af[2], bfr[2];
#pragma unroll
            for (int pt = 0; pt < 2; ++pt) af[pt] = *(const bf16x8*)(Ta + (pt * 32 + r32) * 144 + ko);
#pragma unroll
            for (int ct = 0; ct < 2; ++ct) bfr[ct] = *(const bf16x8*)(Bm + (half * 64 + ct * 32 + r32) * 144 + ko);
#pragma unroll
            for (int pt = 0; pt < 2; ++pt)
#pragma unroll
                for (int ct = 0; ct < 2; ++ct) acc[pt][ct] = MFMA32(af[pt], bfr[ct], acc[pt][ct]);
        }
        if (which == 0) {
            bf16_t* Uc = (bf16_t*)(ws + OFF_UC) + ci * 8192;
#pragma unroll
            for (int pt = 0; pt < 2; ++pt)
#pragma unroll
                for (int ct = 0; ct < 2; ++ct) {
                    const f32x16& a = acc[pt][ct];
                    u32x4* d = (u32x4*)(Uc + (((half * 2 + ct) * 2 + pt) * 64 + lane) * 16);
                    d[0] = (u32x4){cvtpk(a[0], a[1]), cvtpk(a[2], a[3]), cvtpk(a[4], a[5]), cvtpk(a[6], a[7])};
                    d[1] = (u32x4){cvtpk(a[8], a[9]), cvtpk(a[10], a[11]), cvtpk(a[12], a[13]), cvtpk(a[14], a[15])};
                }
        } else {
            bf16_t* Wc = (bf16_t*)(ws + OFF_WC) + ci * 8192;
#pragma unroll
            for (int pt = 0; pt < 2; ++pt)
#pragma unroll
                for (int ct = 0; ct < 2; ++ct)
#pragma unroll
                    for (int i = 0; i < 16; ++i) Wc[(pt * 32 + crow(i, hh)) * 128 + half * 64 + ct * 32 + r32] = f2bf(-acc[pt][ct][i]);
        }
    }
}

constexpr int SL_W = 0, SL_QG = 16896, SL_KDT = 33792, SL_AT = 51200, SL_BUF = 59904;

DI void dn_scan_item(const Params& p, int seqbase, int T, int h, int dir, char* lds) {
    int tid_ = threadIdx.x; asm volatile("" : "+v"(tid_));
    const int tid = tid_, wid = __builtin_amdgcn_readfirstlane(tid >> 6), lane0 = tid & 63;
    char* ws = p.ws;
    const int N = T >> 6, gch0 = seqbase >> 6;
    const bf16_t* qd = (const bf16_t*)p.out; const bf16_t* kd = (const bf16_t*)((char*)p.out + U1);
    const bf16_t* WcB = (const bf16_t*)(ws + OFF_WC); const bf16_t* UcB = (const bf16_t*)(ws + OFF_UC);
    const bf16_t* AcB = (const bf16_t*)(ws + OFF_AC); const float* GcB = (const float*)(ws + OFF_GC);
    bf16_t* Oout = (bf16_t*)(ws + (dir ? OFF_OB : OFF_OF));
    const bool loader = wid >= 4;
    const int lt0 = tid - 256;

    struct LRegs { u32x4 rw[4], rq[4], rk[4], rat[2]; float gq[4]; float glast; };
    auto issue = [&](int n, LRegs& R) {
        int lt = lt0; asm volatile("" : "+v"(lt));
        const int cn = dir ? N - 1 - n : n; const int gchunk = gch0 + cn;
        const size_t ci = (size_t)(gchunk * 4 + h) * 2 + dir;
        const bf16_t* Wc = WcB + ci * 8192; const bf16_t* Ac = AcB + ci * 4096; const float* gc = GcB + ci * 64;
        R.glast = gc[63];
#pragma unroll
        for (int i = 0; i < 4; ++i) {
            const int q = lt + 256 * i, row = q >> 4, c16 = q & 15;
            const int tl = dir ? 63 - row : row; const size_t m = (size_t)gchunk * 64 + tl;
            R.rw[i] = *(const u32x4*)(Wc + row * 128 + c16 * 8);
            R.rq[i] = *(const u32x4*)(qd + m * 512 + h * 128 + c16 * 8);
            R.rk[i] = *(const u32x4*)(kd + m * 512 + h * 128 + c16 * 8);
            R.gq[i] = gc[row];
        }
#pragma unroll
        for (int i = 0; i < 2; ++i) { const int q = lt + 256 * i, row = q >> 3, c16 = q & 7; R.rat[i] = *(const u32x4*)(Ac + row * 64 + c16 * 8); }
    };
    auto commit = [&](int par, const LRegs& R) {
        int lt = lt0; asm volatile("" : "+v"(lt));
        char* buf = lds + par * SL_BUF;
#pragma unroll
        for (int i = 0; i < 4; ++i) {
            const int q = lt + 256 * i, row = q >> 4, c16 = q & 15;
            char* wd = buf + SL_W + row * 264 + c16 * 16;
            *(u32x2*)wd = (u32x2){R.rw[i].x, R.rw[i].y}; *(u32x2*)(wd + 8) = (u32x2){R.rw[i].z, R.rw[i].w};
            const float eq = __expf(R.gq[i]), ek = __expf(R.glast - R.gq[i]);
            unsigned qq[4] = {R.rq[i].x, R.rq[i].y, R.rq[i].z, R.rq[i].w}, kk[4] = {R.rk[i].x, R.rk[i].y, R.rk[i].z, R.rk[i].w};
            unsigned qo[4];
#pragma unroll
            for (int e = 0; e < 4; ++e) qo[e] = cvtpk(bflo(qq[e]) * eq, bfhi(qq[e]) * eq);
            char* qdst = buf + SL_QG + row * 264 + c16 * 16;
            *(u32x2*)qdst = (u32x2){qo[0], qo[1]}; *(u32x2*)(qdst + 8) = (u32x2){qo[2], qo[3]};
#pragma unroll
            for (int e = 0; e < 4; ++e) {
                const unsigned pk = cvtpk(bflo(kk[e]) * ek, bfhi(kk[e]) * ek);
                *(bf16_t*)(buf + SL_KDT + (c16 * 8 + 2 * e) * 136 + row * 2) = (bf16_t)(pk & 0xffffu);
                *(bf16_t*)(buf + SL_KDT + (c16 * 8 + 2 * e + 1) * 136 + row * 2) = (bf16_t)(pk >> 16);
            }
        }
#pragma unroll
        for (int i = 0; i < 2; ++i) {
            const int q = lt + 256 * i, row = q >> 3, c16 = q & 7;
            char* ad = buf + SL_AT + row * 136 + c16 * 16;
            *(u32x2*)ad = (u32x2){R.rat[i].x, R.rat[i].y}; *(u32x2*)(ad + 8) = (u32x2){R.rat[i].z, R.rat[i].w};
        }
    };

    f32x16 S[4];
#pragma unroll
    for (int d = 0; d < 4; ++d)
#pragma unroll
        for (int i = 0; i < 16; ++i) S[d][i] = 0.f;
    const int slab = wid & 3;
    struct URegs { u32x4 un[2][2]; float gl; };
    auto uload = [&](int n, URegs& U) {
        int lane = lane0; asm volatile("" : "+v"(lane));
        const int cn = dir ? N - 1 - n : n; const size_t ci = (size_t)((gch0 + cn) * 4 + h) * 2 + dir;
        const bf16_t* Uc = UcB + ci * 8192;
#pragma unroll
        for (int pt = 0; pt < 2; ++pt) { const u32x4* sp = (const u32x4*)(Uc + ((slab * 2 + pt) * 64 + lane) * 16); U.un[pt][0] = sp[0]; U.un[pt][1] = sp[1]; }
        U.gl = GcB[ci * 64 + 63];
    };
    auto compute = [&](int n, int par, URegs& U) {
        int lane = lane0; asm volatile("" : "+v"(lane));
        const int r32 = lane & 31, hh = lane >> 5;
        const char* buf = lds + par * SL_BUF;
        f32x16 vn[2], o[2];
#pragma unroll
        for (int pt = 0; pt < 2; ++pt) {
            const unsigned uu[8] = {U.un[pt][0].x, U.un[pt][0].y, U.un[pt][0].z, U.un[pt][0].w, U.un[pt][1].x, U.un[pt][1].y, U.un[pt][1].z, U.un[pt][1].w};
#pragma unroll
            for (int e = 0; e < 8; ++e) { vn[pt][2 * e] = bflo(uu[e]); vn[pt][2 * e + 1] = bfhi(uu[e]); }
#pragma unroll
            for (int i = 0; i < 16; ++i) o[pt][i] = 0.f;
        }
        const float gl = __expf(U.gl);
        if (n + 2 < N) uload(n + 2, U);
#pragma unroll
        for (int ks = 0; ks < 8; ++ks) {
            const bf16x8 sb = pack8(S[ks >> 1], ks & 1);
            const int off = (ks * 16 + 4 * hh) * 2;
#pragma unroll
            for (int pt = 0; pt < 2; ++pt) {
                const char* wr = buf + SL_W + (pt * 32 + r32) * 264 + off;
                const char* qr = buf + SL_QG + (pt * 32 + r32) * 264 + off;
                vn[pt] = MFMA32(ld2x64(wr, wr + 16), sb, vn[pt]);
                o[pt] = MFMA32(ld2x64(qr, qr + 16), sb, o[pt]);
            }
        }
        bf16x8 vb[4];
#pragma unroll
        for (int kp = 0; kp < 4; ++kp) vb[kp] = pack8(vn[kp >> 1], kp & 1);
#pragma unroll
        for (int d = 0; d < 4; ++d) S[d] = S[d] * gl;
#pragma unroll
        for (int kp = 0; kp < 4; ++kp) {
            const int off = (kp * 16 + 4 * hh) * 2;
#pragma unroll
            for (int pt = 0; pt < 2; ++pt) { const char* ar = buf + SL_AT + (pt * 32 + r32) * 136 + off; o[pt] = MFMA32(ld2x64(ar, ar + 16), vb[kp], o[pt]); }
#pragma unroll
            for (int d = 0; d < 4; ++d) { const char* kr = buf + SL_KDT + (d * 32 + r32) * 136 + off; S[d] = MFMA32(ld2x64(kr, kr + 16), vb[kp], S[d]); }
        }
        const int cn = dir ? N - 1 - n : n; const size_t mrow0 = (size_t)(gch0 + cn) * 64;
#pragma unroll
        for (int pt = 0; pt < 2; ++pt)
#pragma unroll
            for (int i = 0; i < 16; ++i) {
                const int pi = pt * 32 + crow(i, hh), tl = dir ? 63 - pi : pi;
                Oout[(mrow0 + tl) * 512 + h * 128 + slab * 32 + r32] = f2bf(o[pt][i]);
            }
    };
    __syncthreads();
    if (loader) {
        LRegs RA, RB;
        issue(0, RA); issue(1, RB); commit(0, RA); issue(2, RA);
        __syncthreads();
        for (int n = 0; n < N; n += 2) {
            commit(1, RB); if (n + 3 < N) issue(n + 3, RB);
            __syncthreads();
            if (n + 2 < N) { commit(0, RA); if (n + 4 < N) issue(n + 4, RA); }
            __syncthreads();
        }
    } else {
        URegs UA, UB;
        uload(0, UA); uload(1, UB);
        __syncthreads();
        for (int n = 0; n < N; n += 2) {
            compute(n, 0, UA);
            __syncthreads();
            compute(n + 1, 1, UB);
            __syncthreads();
        }
    }
}

constexpr int LDA_ = 1024, LDO_ = 1024;
constexpr size_t SHM_V = 64 * 128 * 2, SHM_K = 64 * 128 * 2;
#define KSWZ(row, colB) ((row) * 256 + ((colB) ^ (((row) & 7) << 4)))
#define SBAR() __builtin_amdgcn_sched_barrier(0)

DI unsigned cvtpk_a(float lo, float hi) { unsigned r; asm volatile("v_cvt_pk_bf16_f32 %0, %1, %2" : "=v"(r) : "v"(lo), "v"(hi)); return r; }
DI float smA_max0(const f32x16& p0) {
    float mx = p0[0];
#pragma unroll
    for (int r = 1; r < 16; ++r) mx = fmaxf(mx, p0[r]);
    return mx;
}
DI float smA_max1(float mx, const f32x16& p1) {
#pragma unroll
    for (int r = 0; r < 16; ++r) mx = fmaxf(mx, p1[r]);
    auto rr = __builtin_amdgcn_permlane32_swap(__float_as_uint(mx), __float_as_uint(mx), false, false);
    return fmaxf(__uint_as_float(rr[0]), __uint_as_float(rr[1]));
}
template <int LO> DI void smA_exp(f32x16& p0) {
#pragma unroll
    for (int r = LO; r < LO + 8; ++r) p0[r] = __builtin_amdgcn_exp2f(p0[r]);
}
template <bool FIRST> DI void smB(f32x16& p0, f32x16& p1, float pmax, float& m_reg, float& alpha) {
    if (!FIRST && __builtin_expect(__all(pmax <= ATHR2), 1)) { alpha = 1.f; }
    else {
        const float delta = FIRST ? pmax : fmaxf(pmax, 0.f);
        alpha = __builtin_amdgcn_exp2f(-delta); m_reg += delta;
#pragma unroll
        for (int r = 0; r < 16; ++r) { p0[r] *= alpha; p1[r] -= delta; }
    }
}
template <bool FIRST> DI void partialSM(f32x16& p0, f32x16& p1, float& m_reg, float& alpha) {
    const float pmax = smA_max1(smA_max0(p0), p1);
    smA_exp<0>(p0); smA_exp<8>(p0);
    smB<FIRST>(p0, p1, pmax, m_reg, alpha);
}
DI void finishSM(f32x16& p0, f32x16& p1, float alpha, float& l_reg, bf16x8& pa0, bf16x8& pa1, bf16x8& pa2, bf16x8& pa3) {
#pragma unroll
    for (int r = 0; r < 16; ++r) p1[r] = __builtin_amdgcn_exp2f(p1[r]);
    float ps = 0;
#pragma unroll
    for (int r = 0; r < 16; ++r) ps += p0[r];
#pragma unroll
    for (int r = 0; r < 16; ++r) ps += p1[r];
    { auto rr = __builtin_amdgcn_permlane32_swap(__float_as_uint(ps), __float_as_uint(ps), false, false);
      ps = __uint_as_float(rr[0]) + __uint_as_float(rr[1]); }
    l_reg = l_reg * alpha + ps;
#define PK4(P, BASE, OUT) do { unsigned a0 = cvtpk_a(P[BASE + 0], P[BASE + 1]), a1 = cvtpk_a(P[BASE + 2], P[BASE + 3]);   \
    unsigned b0 = cvtpk_a(P[BASE + 4], P[BASE + 5]), b1 = cvtpk_a(P[BASE + 6], P[BASE + 7]);                              \
    auto r0 = __builtin_amdgcn_permlane32_swap(a0, b0, false, false); auto r1 = __builtin_amdgcn_permlane32_swap(a1, b1, false, false); \
    u32x4 w = {r0[0], r1[0], r0[1], r1[1]}; OUT = __builtin_bit_cast(bf16x8, w); } while (0)
    PK4(p0, 0, pa0); PK4(p0, 8, pa1); PK4(p1, 0, pa2); PK4(p1, 8, pa3);
#undef PK4
}
DI void qkt(f32x16& p0, f32x16& p1, const char* Ks, const bf16x8* qr, float negm, int r32, int hi) {
#pragma unroll
    for (int i = 0; i < 16; ++i) { p0[i] = negm; p1[i] = negm; }
#pragma unroll
    for (int d0 = 0; d0 < 8; ++d0) { const int cb = (d0 * 16 + hi * 8) * 2;
        bf16x8 b0 = *(const bf16x8*)(Ks + KSWZ(r32, cb));
        bf16x8 b1 = *(const bf16x8*)(Ks + KSWZ(32 + r32, cb));
        p0 = MFMA32(b0, qr[d0], p0);
        p1 = MFMA32(b1, qr[d0], p1); }
}
DI int v_st(int k, int c) { const int kk = (k & ~0xC) | ((k & 4) << 1) | ((k & 8) >> 1); return ((kk >> 3) * 4 + (c >> 5)) * 512 + ((kk & 7) * 32 + (c & 31)) * 2; }
DI int v_rd_base(int lane) { return ((lane & 3) << 3) | (((lane >> 2) & 3) << 6) | (((lane >> 4) & 1) << 5) | (((lane >> 5) & 1) << 8); }
constexpr int v_rd_off(int d0, int ks, int half) { return d0 * 512 + ks * 4096 + half * 2048; }
template <int OFF> DI s16x4 tr_read(int vb) { s16x4 r; asm volatile("ds_read_b64_tr_b16 %0, %1 offset:%2" : "=&v"(r) : "v"(vb), "i"(OFF) : "memory"); return r; }
template <int D0> DI void pv_one(f32x16& od, int vb, bf16x8 pa0, bf16x8 pa1, bf16x8 pa2, bf16x8 pa3) {
    const s16x4 l0 = tr_read<v_rd_off(D0, 0, 0)>(vb), h0 = tr_read<v_rd_off(D0, 0, 1)>(vb), l1 = tr_read<v_rd_off(D0, 1, 0)>(vb), h1 = tr_read<v_rd_off(D0, 1, 1)>(vb);
    const s16x4 l2 = tr_read<v_rd_off(D0, 2, 0)>(vb), h2 = tr_read<v_rd_off(D0, 2, 1)>(vb), l3 = tr_read<v_rd_off(D0, 3, 0)>(vb), h3 = tr_read<v_rd_off(D0, 3, 1)>(vb);
    asm volatile("s_waitcnt lgkmcnt(0)" ::: "memory"); SBAR();
#define PK(L, H) (bf16x8){L[0], L[1], L[2], L[3], H[0], H[1], H[2], H[3]}
    od = MFMA32(pa0, PK(l0, h0), od);
    od = MFMA32(pa1, PK(l1, h1), od);
    od = MFMA32(pa2, PK(l2, h2), od);
    od = MFMA32(pa3, PK(l3, h3), od);
#undef PK
}
DI float pv_d0_sm(f32x16* o, int vb, bf16x8 pa0, bf16x8 pa1, bf16x8 pa2, bf16x8 pa3, f32x16& q0, f32x16& q1) {
    pv_one<0>(o[0], vb, pa0, pa1, pa2, pa3); const float mx0 = smA_max0(q0);
    pv_one<1>(o[1], vb, pa0, pa1, pa2, pa3); const float pmax = smA_max1(mx0, q1);
    pv_one<2>(o[2], vb, pa0, pa1, pa2, pa3); smA_exp<0>(q0);
    pv_one<3>(o[3], vb, pa0, pa1, pa2, pa3); smA_exp<8>(q0);
    return pmax;
}
DI void pv_d0(f32x16* o, int vb, bf16x8 pa0, bf16x8 pa1, bf16x8 pa2, bf16x8 pa3) {
    pv_one<0>(o[0], vb, pa0, pa1, pa2, pa3); pv_one<1>(o[1], vb, pa0, pa1, pa2, pa3); pv_one<2>(o[2], vb, pa0, pa1, pa2, pa3); pv_one<3>(o[3], vb, pa0, pa1, pa2, pa3);
}

DI void attn_unit(const bf16_t* __restrict__ Qb, const bf16_t* __restrict__ Kh, const bf16_t* __restrict__ Vh, bf16_t* __restrict__ Ob, const float* __restrict__ onw, int seq, char* lds) {
    int tid_ = threadIdx.x; asm volatile("" : "+v"(tid_));
    const int tid = tid_, wid = tid >> 6, lane = tid & 63, r32 = lane & 31, hi = lane >> 5;
    char* V_lds = lds; char* K_lds = lds + 2 * SHM_V;
    float* wsf = (float*)(lds + 2 * SHM_V + 2 * SHM_K) + wid * 64; float* li_l = wsf; float* al_l = wsf + 32;
    float m_reg = 0.f, l_reg = 0; f32x16 o[4]; bf16x8 qr[8];
#pragma unroll
    for (int d = 0; d < 4; ++d)
#pragma unroll
        for (int i = 0; i < 16; ++i) o[d][i] = 0.f;
    const bf16_t* Qw = Qb + (long)((wid & 3) * 32 + r32) * LDA_ + (wid >> 2) * 128 + hi * 8;
#pragma unroll
    for (int d0 = 0; d0 < 8; ++d0) qr[d0] = *(const bf16x8*)(Qw + d0 * 16);
    const int sr = tid >> 4, sc = (tid & 15) * 8, vst0 = v_st(sr, sc), vst1 = v_st(32 + sr, sc);
    const int vb0 = (int)(uintptr_t)V_lds + v_rd_base(lane);
    struct { bf16x8 vs0, vs1, ks0, ks1; } sr_[1];
#define SLOAD(i, k0) do { sr_[i].vs0 = *(const bf16x8*)(&Vh[(long)((k0) + sr) * LDA_ + sc]); sr_[i].vs1 = *(const bf16x8*)(&Vh[(long)((k0) + 32 + sr) * LDA_ + sc]); \
    sr_[i].ks0 = *(const bf16x8*)(&Kh[(long)((k0) + sr) * LDA_ + sc]); sr_[i].ks1 = *(const bf16x8*)(&Kh[(long)((k0) + 32 + sr) * LDA_ + sc]); } while (0)
#define SWRITE(b, i) do { *(bf16x8*)(V_lds + (b) * SHM_V + vst0) = sr_[i].vs0;          \
    *(bf16x8*)(V_lds + (b) * SHM_V + vst1) = sr_[i].vs1; int kc = sc * 2;               \
    *(bf16x8*)(K_lds + (b) * SHM_K + KSWZ(sr, kc)) = sr_[i].ks0;                       \
    *(bf16x8*)(K_lds + (b) * SHM_K + KSWZ(32 + sr, kc)) = sr_[i].ks1; } while (0)
#define SWAIT() asm volatile("s_waitcnt vmcnt(0)" ::: "memory")
#define RESC(a) do { if (__any((a) < 1.f)) { if (hi == 0) al_l[r32] = (a); asm volatile("s_waitcnt lgkmcnt(0)" ::: "memory"); \
    _Pragma("unroll") for (int d = 0; d < 4; ++d) _Pragma("unroll") for (int r = 0; r < 16; ++r) o[d][r] *= al_l[crow(r, hi)]; } } while (0)
    f32x16 pA0, pA1, pB0, pB1; float alA, alB; bf16x8 pa0, pa1, pa2, pa3; const int NT = seq / 64;
    constexpr int SE = 0, SO = 0;
    SLOAD(SE, 0); asm volatile("s_waitcnt vmcnt(0)" ::: "memory"); SWRITE(0, SE); __syncthreads();
    qkt(pA0, pA1, K_lds, qr, 0.f, r32, hi); partialSM<true>(pA0, pA1, m_reg, alA);
    SLOAD(SO, 64);
    SWAIT(); SWRITE(1, SO); __syncthreads();
    for (int j = 1; j + 1 < NT; j += 2) {
        SBAR(); qkt(pB0, pB1, K_lds + SHM_K, qr, -m_reg, r32, hi);
        finishSM(pA0, pA1, alA, l_reg, pa0, pa1, pa2, pa3); SBAR();
        SLOAD(SO, (j + 1) * 64); SBAR();
        { const float pm = pv_d0_sm(o, vb0, pa0, pa1, pa2, pa3, pB0, pB1); smB<false>(pB0, pB1, pm, m_reg, alB); }
        __syncthreads(); SWAIT(); SWRITE(0, SE);
        RESC(alB); __syncthreads();
        SBAR(); qkt(pA0, pA1, K_lds, qr, -m_reg, r32, hi);
        finishSM(pB0, pB1, alB, l_reg, pa0, pa1, pa2, pa3); SBAR();
        SLOAD(SE, (j + 2) * 64); SBAR();
        { const float pm = pv_d0_sm(o, vb0 + (int)SHM_V, pa0, pa1, pa2, pa3, pA0, pA1); smB<false>(pA0, pA1, pm, m_reg, alA); }
        __syncthreads(); SWAIT(); SWRITE(1, SO);
        RESC(alA); __syncthreads();
    }
    SBAR(); qkt(pB0, pB1, K_lds + SHM_K, qr, -m_reg, r32, hi);
    finishSM(pA0, pA1, alA, l_reg, pa0, pa1, pa2, pa3); SBAR();
    { const float pm = pv_d0_sm(o, vb0, pa0, pa1, pa2, pa3, pB0, pB1); smB<false>(pB0, pB1, pm, m_reg, alB); }
    __syncthreads(); RESC(alB);
    finishSM(pB0, pB1, alB, l_reg, pa0, pa1, pa2, pa3); SBAR();
    pv_d0(o, vb0 + (int)SHM_V, pa0, pa1, pa2, pa3);
    if (hi == 0) li_l[r32] = l_reg; asm volatile("s_waitcnt lgkmcnt(0)" ::: "memory");
    float wn[4];
#pragma unroll
    for (int d0 = 0; d0 < 4; ++d0) wn[d0] = onw[d0 * 32 + r32];
    bf16_t* Ow = Ob + (long)((wid & 3) * 32) * LDO_ + (wid >> 2) * 128;
#pragma unroll
    for (int r = 0; r < 16; ++r) {
        const int orow = crow(r, hi);
        const float rl = __builtin_amdgcn_rcpf(li_l[orow]);
        float v[4]; float ss = 0.f;
#pragma unroll
        for (int d0 = 0; d0 < 4; ++d0) { v[d0] = o[d0][r] * rl; ss += v[d0] * v[d0]; }
#pragma unroll
        for (int of = 16; of >= 1; of >>= 1) ss += __shfl_xor(ss, of);
        const float rs = rsqrtf(ss * (1.f / 128.f) + 1e-6f);
#pragma unroll
        for (int d0 = 0; d0 < 4; ++d0) Ow[(long)orow * LDO_ + d0 * 32 + r32] = f2bf(v[d0] * rs * wn[d0]);
    }
#undef SLOAD
#undef SWRITE
#undef SWAIT
#undef RESC
}

DI void phase_dn_combine(const Params& p) {
    char* ws = p.ws;
    const bf16_t* of = (const bf16_t*)(ws + OFF_OF); const bf16_t* ob = (const bf16_t*)(ws + OFF_OB); const bf16_t* z = (const bf16_t*)(ws + OFF_Z);
    bf16_t* mix = (bf16_t*)(ws + OFF_MIX);
    const int j = threadIdx.x & 15;
    const int gid = (blockIdx.x * NTHR + threadIdx.x) >> 4, ng = (gridDim.x * NTHR) >> 4;
    float nw[8];
#pragma unroll
    for (int e = 0; e < 8; ++e) nw[e] = p.dn_norm_w[j * 8 + e];
    for (int u0 = gid; u0 < M_TOK * 4; u0 += 2 * ng) {
        u32x4 a[2], b[2], zz[2]; bool ok[2];
#pragma unroll
        for (int q = 0; q < 2; ++q) {
            const int u = u0 + q * ng; ok[q] = u < M_TOK * 4;
            if (ok[q]) { const size_t off = (size_t)u * 128 + j * 8; a[q] = *(const u32x4*)(of + off); b[q] = *(const u32x4*)(ob + off); zz[q] = *(const u32x4*)(z + off); }
            else { a[q] = (u32x4){0u, 0u, 0u, 0u}; b[q] = a[q]; zz[q] = a[q]; }
        }
#pragma unroll
        for (int q = 0; q < 2; ++q) {
            const int u = u0 + q * ng;
            const unsigned aa[4] = {a[q].x, a[q].y, a[q].z, a[q].w}, bb[4] = {b[q].x, b[q].y, b[q].z, b[q].w}, zq[4] = {zz[q].x, zz[q].y, zz[q].z, zz[q].w};
            float v[8], zf[8]; float ss = 0.f;
#pragma unroll
            for (int e = 0; e < 4; ++e) { v[2 * e] = bflo(aa[e]) + bflo(bb[e]); v[2 * e + 1] = bfhi(aa[e]) + bfhi(bb[e]); zf[2 * e] = bflo(zq[e]); zf[2 * e + 1] = bfhi(zq[e]); }
#pragma unroll
            for (int e = 0; e < 8; ++e) ss += v[e] * v[e];
#pragma unroll
            for (int o = 8; o >= 1; o >>= 1) ss += __shfl_xor(ss, o);
            const float rs = rsqrtf(ss * (1.f / 128.f) + 1e-6f);
            float r[8];
#pragma unroll
            for (int e = 0; e < 8; ++e) r[e] = v[e] * rs * nw[e] * silu_f(zf[e]);
            if (ok[q]) *(u32x4*)(mix + (size_t)(u >> 2) * 1024 + 512 + (u & 3) * 128 + j * 8) = (u32x4){cvtpk(r[0], r[1]), cvtpk(r[2], r[3]), cvtpk(r[4], r[5]), cvtpk(r[6], r[7])};
        }
    }
}

DI void phase_ffn_act(const Params& p, int slab) {
    char* ws = p.ws;
    const bf16_t* us = (const bf16_t*)(ws + OFF_US); bf16_t* act = (bf16_t*)(ws + OFF_ACT);
    constexpr int NG = DFFP / 8;
    const int nthreads = gridDim.x * NTHR, tpg = nthreads / NG;
    const int gt = blockIdx.x * NTHR + threadIdx.x, cg8 = gt % NG, sidx = gt / NG;
    if (sidx >= tpg) return;
    const int seglen = (MSLAB + tpg - 1) / tpg;
    const int t_beg = sidx * seglen, t_end = min(MSLAB, t_beg + seglen);
    const int c8 = cg8 * 8, m0 = slab * MSLAB;
    if (c8 >= DFF) { for (int ml = t_beg; ml < t_end; ++ml) *(u32x4*)(act + (size_t)ml * DFFP + c8) = (u32x4){0u, 0u, 0u, 0u}; return; }
    float wg[3][8], wu[3][8], bg[8], bu[8];
#pragma unroll
    for (int e = 0; e < 8; ++e) { bg[e] = p.ffn_conv_b[c8 + e]; bu[e] = p.ffn_conv_b[DFF + c8 + e]; }
#pragma unroll
    for (int j = 0; j < 3; ++j)
#pragma unroll
        for (int e = 0; e < 8; ++e) { wg[j][e] = p.ffn_conv_w[(size_t)j * DFF2 + c8 + e]; wu[j][e] = p.ffn_conv_w[(size_t)j * DFF2 + DFF + c8 + e]; }
    auto ldrow = [&](int ml, u32x4& g, u32x4& u) {
        if (ml >= 0 && ml < MSLAB) { const bf16_t* row = us + (size_t)ml * DFF2; g = *(const u32x4*)(row + c8); u = *(const u32x4*)(row + DFF + c8); }
        else { g = (u32x4){0u, 0u, 0u, 0u}; u = g; }
    };
    u32x4 gp, up, gc, uc, gn, un, gn2, un2, gn3, un3, gn4, un4;
    ldrow(t_beg - 1, gp, up); ldrow(t_beg, gc, uc); ldrow(t_beg + 1, gn, un); ldrow(t_beg + 2, gn2, un2); ldrow(t_beg + 3, gn3, un3);
    for (int ml = t_beg; ml < t_end; ++ml) {
        ldrow(ml + 4, gn4, un4);
        int base, t, T; seq_of(m0 + ml, base, t, T);
        const float mp = t > 0 ? 1.f : 0.f, mn = t + 1 < T ? 1.f : 0.f;
        const unsigned gpa[4] = {gp.x, gp.y, gp.z, gp.w}, gca[4] = {gc.x, gc.y, gc.z, gc.w}, gna[4] = {gn.x, gn.y, gn.z, gn.w};
        const unsigned upa[4] = {up.x, up.y, up.z, up.w}, uca[4] = {uc.x, uc.y, uc.z, uc.w}, una[4] = {un.x, un.y, un.z, un.w};
        float r[8];
#pragma unroll
        for (int e = 0; e < 4; ++e) {
            const float g0 = bg[2 * e] + mp * bflo(gpa[e]) * wg[0][2 * e] + bflo(gca[e]) * wg[1][2 * e] + mn * bflo(gna[e]) * wg[2][2 * e];
            const float g1 = bg[2 * e + 1] + mp * bfhi(gpa[e]) * wg[0][2 * e + 1] + bfhi(gca[e]) * wg[1][2 * e + 1] + mn * bfhi(gna[e]) * wg[2][2 * e + 1];
            const float u0 = bu[2 * e] + mp * bflo(upa[e]) * wu[0][2 * e] + bflo(uca[e]) * wu[1][2 * e] + mn * bflo(una[e]) * wu[2][2 * e];
            const float u1 = bu[2 * e + 1] + mp * bfhi(upa[e]) * wu[0][2 * e + 1] + bfhi(uca[e]) * wu[1][2 * e + 1] + mn * bfhi(una[e]) * wu[2][2 * e + 1];
            r[2 * e] = silu_f(g0) * u0; r[2 * e + 1] = silu_f(g1) * u1;
        }
        *(u32x4*)(act + (size_t)ml * DFFP + c8) = (u32x4){cvtpk(r[0], r[1]), cvtpk(r[2], r[3]), cvtpk(r[4], r[5]), cvtpk(r[6], r[7])};
        gp = gc; up = uc; gc = gn; uc = un; gn = gn2; un = un2; gn2 = gn3; un2 = un3; gn3 = gn4; un3 = un4;
    }
}

constexpr int NPHASE = 14;
constexpr int Q_DNS = 16, Q_ATS = 512, Q_DNP = 256, Q_ATP = 1024, Q_TOTAL = Q_DNS + Q_ATS + Q_DNP + Q_ATP;

DI void run_phase(const Params& p, int ph, char* lds) {
    char* ws = p.ws;
    switch (ph) {
    case 0: phase0(p, lds); break;
    case 1: {
        FInProj f{(bf16_t*)((char*)p.out + 2 * U1), (bf16_t*)(ws + OFF_PROJD), (bf16_t*)(ws + OFF_Z), (float*)(ws + OFF_GATES)};
        run_gemm(lds, (const bf16_t*)p.out, (const bf16_t*)(ws + OFF_WIN), 1024, M_TOK / 256, INWP / 256, f);
    } break;
    case 2: {
        phase_attn_prep(p);
        {
            u32x2 xr[20];
#pragma unroll
            for (int r = 0; r < 20; ++r) xr[r] = (u32x2){0u, 0u};
            if ((int)blockIdx.x < NCHUNK * 4) dn_prep_load(p, blockIdx.x >> 2, blockIdx.x & 3, xr);
            for (int u = blockIdx.x; u < NCHUNK * 4; u += gridDim.x) {
                const int un = u + gridDim.x;
                dn_prep_unit(p, u >> 2, u & 3, lds, xr, un < NCHUNK * 4 ? (un >> 2) : -1, un & 3);
            }
        }
    } break;
    case 3: {
        unsigned* ctr = (unsigned*)(ws + OFF_CTR);
        int* item_s = (int*)(lds + LDS_BYTES - 16);
        const bf16_t* bufA = (const bf16_t*)((char*)p.out + 2 * U1);
        bf16_t* ao = (bf16_t*)(ws + OFF_MIX);
        for (;;) {
            __syncthreads();
            if (threadIdx.x == 0) *item_s = (int)atomicAdd(ctr, 1u);
            __syncthreads();
            const int it = __builtin_amdgcn_readfirstlane(*item_s);
            if (it >= Q_TOTAL) break;
#ifndef SKIP_SCAN
            if (it < Q_DNS) { const int sq = it >> 3; dn_scan_item(p, MP + sq * 16384, 16384, (it >> 1) & 3, it & 1, lds); }
#else
            if (it < Q_DNS) {}
#endif
            else if (it >= Q_DNS + Q_ATS && it < Q_DNS + Q_ATS + Q_DNP) {
#ifndef SKIP_SCAN
                const int u = it - Q_DNS - Q_ATS; dn_scan_item(p, (u >> 3) * 2048, 2048, (u >> 1) & 3, u & 1, lds);
#endif
            } else {
                size_t r0; int kvh, qb, seq;
                if (it < Q_DNS + Q_ATS) { const int u = it - Q_DNS, bk = u >> 7; qb = u & 127; kvh = bk & 1; r0 = (size_t)MP + (size_t)(bk >> 1) * 16384; seq = 16384; }
                else { const int u = it - Q_DNS - Q_ATS - Q_DNP, bk = u >> 4; qb = u & 15; kvh = bk & 1; r0 = (size_t)(bk >> 1) * 2048; seq = 2048; }
#ifndef SKIP_ATTN
                attn_unit(bufA + (r0 + qb * 128) * 1024 + kvh * 256, bufA + r0 * 1024 + 512 + kvh * 128, bufA + r0 * 1024 + 768 + kvh * 128,
                          ao + (r0 + qb * 128) * 1024 + kvh * 256, p.o_norm_w, seq, lds);
#endif
            }
        }
    } break;
    case 4: phase_dn_combine(p); break;
    case 5: {
        pg8::Gemm g{(const bf16_t*)(ws + OFF_MIX), (const bf16_t*)(ws + OFF_WOUT), M_TOK, 1024, 1024};
        pg8::XcdOrder S; S.init(M_TOK / 256, 4);
        EpiOutProj E{p.x_prompt, p.x_sample, p.out, (bf16_t*)(ws + OFF_H2), (float*)(ws + OFF_SS)};
        pg8::gemm_phase<EpiOutProj, pg8::XcdOrder, true, true>((PG8_LAS unsigned char*)lds, g, S, E);
    } break;
    case 6: break;
    case 7: case 10: {
        const int slab = ph == 7 ? 0 : 1;
        FU f{(bf16_t*)(ws + OFF_US), (const float*)(ws + OFF_SS) + (size_t)slab * MSLAB};
        run_gemm(lds, (const bf16_t*)(ws + OFF_H2) + (size_t)slab * MSLAB * 1024, (const bf16_t*)(ws + OFF_WFFI), 1024, MSLAB / 256, DFF2P / 256, f);
    } break;
    case 8: case 11: phase_ffn_act(p, ph == 8 ? 0 : 1); break;
    case 9: case 12: {
        const int slab = ph == 9 ? 0 : 1;
        FResOut f{p.out + (size_t)slab * MSLAB * DM};
        run_gemm(lds, (const bf16_t*)(ws + OFF_ACT), (const bf16_t*)(ws + OFF_WFFO), DFFP, MSLAB / 256, 4, f);
    } break;
    default: break;
    }
}

DI void grid_bar(unsigned* ctr, unsigned target) {
    asm volatile("s_waitcnt vmcnt(0)" ::: "memory");
    __syncthreads();
    if (threadIdx.x == 0) {
        __builtin_amdgcn_fence(__ATOMIC_RELEASE, "agent");
        asm volatile("s_waitcnt vmcnt(0)" ::: "memory");
        __hip_atomic_fetch_add(ctr, 1u, __ATOMIC_RELAXED, __HIP_MEMORY_SCOPE_AGENT);
        while (__hip_atomic_load(ctr, __ATOMIC_RELAXED, __HIP_MEMORY_SCOPE_AGENT) < target) __builtin_amdgcn_s_sleep(4);
        __builtin_amdgcn_fence(__ATOMIC_ACQUIRE, "agent");
        asm volatile("s_waitcnt vmcnt(0)" ::: "memory");
    }
    __syncthreads();
}

__global__ void __launch_bounds__(NTHR) mega(Params p, int ph0, int ph1) {
    extern __shared__ __attribute__((aligned(16))) char lds[];
    cg::grid_group grid = cg::this_grid();
#ifdef ONLY_PH
    run_phase(p, ONLY_PH, lds);
#else
    unsigned* bar = (unsigned*)(p.ws + OFF_CTR + 1024);
    run_phase(p, 0, lds); grid.sync();
    run_phase(p, 1, lds); grid_bar(bar, 1u * gridDim.x);
    run_phase(p, 2, lds); grid_bar(bar, 2u * gridDim.x);
    run_phase(p, 3, lds); grid_bar(bar, 3u * gridDim.x);
    run_phase(p, 4, lds); grid_bar(bar, 4u * gridDim.x);
    run_phase(p, 5, lds); grid_bar(bar, 5u * gridDim.x);
    run_phase(p, 7, lds); grid_bar(bar, 6u * gridDim.x);
    run_phase(p, 8, lds); grid_bar(bar, 7u * gridDim.x);
    run_phase(p, 9, lds); grid_bar(bar, 8u * gridDim.x);
    run_phase(p, 10, lds); grid_bar(bar, 9u * gridDim.x);
    run_phase(p, 11, lds); grid_bar(bar, 10u * gridDim.x);
    run_phase(p, 12, lds);
#endif
}

extern "C" void kernel_launch(void* const* d_in, const int* in_sizes, int n_in, void* d_out, int out_size, void* d_ws, size_t ws_size, hipStream_t stream) {
    static int grid_blocks = 0;
    if (!grid_blocks) {
        hipFuncSetAttribute((const void*)mega, hipFuncAttributeMaxDynamicSharedMemorySize, LDS_BYTES);
        int dev = 0, cus = 0, per_cu = 0;
        hipGetDevice(&dev);
        hipDeviceGetAttribute(&cus, hipDeviceAttributeMultiprocessorCount, dev);
        hipOccupancyMaxActiveBlocksPerMultiprocessor(&per_cu, mega, NTHR, LDS_BYTES);
        if (per_cu < 1) per_cu = 1;
        grid_blocks = cus;
        if (grid_blocks % 8) grid_blocks -= grid_blocks % 8;
    }
    Params p{};
    p.x_prompt = (const float*)d_in[0]; p.x_sample = (const float*)d_in[1]; p.norm1_w = (const float*)d_in[2]; p.w_in = (const float*)d_in[3];
    p.dn_conv_w = (const float*)d_in[4]; p.A_log_f = (const float*)d_in[5]; p.A_log_b = (const float*)d_in[6]; p.dt_f = (const float*)d_in[7];
    p.dt_b = (const float*)d_in[8]; p.dn_norm_w = (const float*)d_in[9]; p.q_norm_w = (const float*)d_in[10]; p.k_norm_w = (const float*)d_in[11];
    p.o_norm_w = (const float*)d_in[12]; p.w_out = (const float*)d_in[13]; p.norm2_w = (const float*)d_in[14]; p.w_ffn_in = (const float*)d_in[15];
    p.ffn_conv_w = (const float*)d_in[16]; p.ffn_conv_b = (const float*)d_in[17]; p.w_ffn_out = (const float*)d_in[18];
    p.out = (float*)d_out; p.ws = (char*)d_ws;
    hipMemsetAsync((char*)d_ws + OFF_CTR, 0, 4096, stream);
    int ph0 = 0, ph1 = NPHASE - 1;
    void* args[] = {&p, &ph0, &ph1};
    hipError_t e = hipLaunchCooperativeKernel((void*)mega, dim3(grid_blocks), dim3(NTHR), args, LDS_BYTES, stream);
    if (e != hipSuccess) fprintf(stderr, "cooperative launch failed: %s (grid %d)\n", hipGetErrorString(e), grid_blocks);
}
```

```cpp
#include <hip/hip_runtime.h>
#include <hip/hip_cooperative_groups.h>
#include <cstdio>
#include <cstdint>
#include <utility>
namespace cg = cooperative_groups;

typedef unsigned short bf16_t;
typedef short bf16x8 __attribute__((ext_vector_type(8)));
typedef short s16x4 __attribute__((ext_vector_type(4)));
typedef float f32x16 __attribute__((ext_vector_type(16)));
typedef float f32x4 __attribute__((ext_vector_type(4)));
typedef float f32x2 __attribute__((ext_vector_type(2)));
typedef unsigned u32x4 __attribute__((ext_vector_type(4)));
typedef unsigned u32x2 __attribute__((ext_vector_type(2)));
typedef __bf16 bfv2 __attribute__((ext_vector_type(2)));
#define DI __device__ __forceinline__
#define MFMA32(a, b, c) __builtin_amdgcn_mfma_f32_32x32x16_bf16((a), (b), (c), 0, 0, 0)

constexpr int M_TOK = 98304, MP = 65536, DM = 1024;
constexpr int INW = 3088, INWP = 3328, DFF = 2752, DFF2 = 5504, DFF2P = 5632;
constexpr int NTHR = 512;
constexpr size_t U1 = (size_t)M_TOK * 512 * 2;
constexpr int LDS_BYTES = 163840;
constexpr int NCHUNK = M_TOK / 64;
constexpr int MSLAB = M_TOK / 2;
constexpr int DFFP = 2816;
constexpr size_t OFF_WIN = 0;
constexpr size_t OFF_WOUT = OFF_WIN + (size_t)INWP * 1024 * 2;
constexpr size_t OFF_WFFI = OFF_WOUT + (size_t)1024 * 1024 * 2;
constexpr size_t OFF_WFFO = OFF_WFFI + (size_t)DFF2P * 1024 * 2;
constexpr size_t OFF_ROPE = OFF_WFFO + (size_t)1024 * DFFP * 2;
constexpr size_t OFF_CTR = OFF_ROPE + 65536;
constexpr size_t OFF_GATES = OFF_CTR + 65536;
constexpr size_t OFF_Z = OFF_GATES + (size_t)M_TOK * 16 * 4;
constexpr size_t OFF_WC = OFF_Z + U1;
constexpr size_t OFF_UC = OFF_WC + 2 * U1;
constexpr size_t OFF_AC = OFF_UC + 2 * U1;
constexpr size_t OFF_GC = OFF_AC + U1;
constexpr size_t OFF_PROJD = OFF_GC + (size_t)NCHUNK * 8 * 64 * 4;
constexpr size_t OFF_MIX = OFF_PROJD, OFF_OF = OFF_PROJD + 2 * U1, OFF_OB = OFF_PROJD + 3 * U1;
constexpr size_t OFF_H2 = OFF_GATES;
constexpr size_t OFF_US = OFF_H2 + 2 * U1;
constexpr size_t OFF_ACT = OFF_US + (size_t)MSLAB * DFF2 * 2;
constexpr size_t OFF_SS = OFF_ACT + (size_t)MSLAB * DFFP * 2;
static_assert(OFF_SS >= OFF_PROJD + 4 * U1 && OFF_SS + (size_t)M_TOK * 4 <= 1073741824ull, "ws map");
static_assert(OFF_PROJD + 4 * U1 <= 1073741824ull, "ws map");
static_assert(OFF_ACT + (size_t)MSLAB * DFFP * 2 <= 1073741824ull, "ws map");
static_assert(OFF_WIN % 256 == 0 && OFF_GATES % 256 == 0 && OFF_PROJD % 256 == 0 && OFF_US % 256 == 0 && OFF_ACT % 256 == 0, "ws align");

struct Params {
    const float* x_prompt; const float* x_sample; const float* norm1_w; const float* w_in; const float* dn_conv_w;
    const float* A_log_f; const float* A_log_b; const float* dt_f; const float* dt_b; const float* dn_norm_w;
    const float* q_norm_w; const float* k_norm_w; const float* o_norm_w; const float* w_out; const float* norm2_w;
    const float* w_ffn_in; const float* ffn_conv_w; const float* ffn_conv_b; const float* w_ffn_out;
    float* out; char* ws;
};

DI float bf2f(bf16_t v) { return __uint_as_float(((unsigned)v) << 16); }
DI unsigned cvtpk(float lo, float hi) { f32x2 v = {lo, hi}; bfv2 r = __builtin_convertvector(v, bfv2); return __builtin_bit_cast(unsigned, r); }
DI bf16_t f2bf(float x) { return (bf16_t)(cvtpk(x, 0.f) & 0xffffu); }
DI float bflo(unsigned w) { return __uint_as_float(w << 16); }
DI float bfhi(unsigned w) { return __uint_as_float(w & 0xffff0000u); }
DI int crow(int r, int hi) { return (r & 3) + 8 * (r >> 2) + 4 * hi; }
DI float silu_f(float v) { return v * __builtin_amdgcn_rcpf(1.f + __expf(-v)); }
DI const float* xrow(const Params& p, int m) { return m < MP ? p.x_prompt + (size_t)m * DM : p.x_sample + (size_t)(m - MP) * DM; }
DI void seq_of(int m, int& base, int& t, int& T) { if (m < MP) { base = m & ~2047; t = m & 2047; T = 2048; } else { int r = m - MP; base = MP + (r & ~16383); t = r & 16383; T = 16384; } }
DI bf16x8 pack8(const f32x16& x, int s) {
    u32x4 w = {cvtpk(x[8 * s], x[8 * s + 1]), cvtpk(x[8 * s + 2], x[8 * s + 3]), cvtpk(x[8 * s + 4], x[8 * s + 5]), cvtpk(x[8 * s + 6], x[8 * s + 7])};
    return __builtin_bit_cast(bf16x8, w);
}
DI bf16x8 ld2x64(const char* p0, const char* p1) { u32x2 a = *(const u32x2*)p0, b = *(const u32x2*)p1; u32x4 w = {a.x, a.y, b.x, b.y}; return __builtin_bit_cast(bf16x8, w); }

DI void transpose_w(const float* in, int K, int N, bf16_t* out, int Kpad, int tile, char* lds, const float* kscale = nullptr) {
    float* tl = (float*)lds;
    const int nkt = Kpad / 64, tid = threadIdx.x;
    const int k0 = (tile % nkt) * 64, n0 = (tile / nkt) * 64;
    __syncthreads();
#pragma unroll
    for (int i = 0; i < 8; ++i) { int nl = tid & 63, kl = (tid >> 6) + 8 * i; int n = n0 + nl; float v = (n < N && k0 + kl < K) ? in[(size_t)(k0 + kl) * N + n] : 0.f; if (kscale) v *= kscale[k0 + kl]; tl[kl * 65 + nl] = v; }
    __syncthreads();
#pragma unroll
    for (int i = 0; i < 8; ++i) { int kl = tid & 63, nl = (tid >> 6) + 8 * i; out[(size_t)(n0 + nl) * Kpad + k0 + kl] = f2bf(tl[kl * 65 + nl]); }
}

DI void rmsnorm_rows(const Params& p, bool from_out, const float* w, bf16_t* dst) {
    const int wid = threadIdx.x >> 6, lane = threadIdx.x & 63;
    const int gw = blockIdx.x * 8 + wid, nw = gridDim.x * 8;
    f32x4 wv[4];
#pragma unroll
    for (int i = 0; i < 4; ++i) wv[i] = *(const f32x4*)(w + i * 256 + lane * 4);
    for (int m0 = gw; m0 < M_TOK; m0 += 2 * nw) {
        f32x4 v[2][4];
#pragma unroll
        for (int q = 0; q < 2; ++q) {
            const int m = min(m0 + q * nw, M_TOK - 1);
            const float* src = from_out ? (const float*)(p.out + (size_t)m * DM) : xrow(p, m);
#pragma unroll
            for (int i = 0; i < 4; ++i) v[q][i] = *(const f32x4*)(src + i * 256 + lane * 4);
        }
#pragma unroll
        for (int q = 0; q < 2; ++q) {
            const int m = m0 + q * nw;
            float ss = 0.f;
#pragma unroll
            for (int i = 0; i < 4; ++i) ss += v[q][i][0] * v[q][i][0] + v[q][i][1] * v[q][i][1] + v[q][i][2] * v[q][i][2] + v[q][i][3] * v[q][i][3];
#pragma unroll
            for (int o = 32; o >= 1; o >>= 1) ss += __shfl_xor(ss, o);
            const float rs = rsqrtf(ss * (1.f / 1024.f) + 1e-6f);
            if (m < M_TOK) {
#pragma unroll
                for (int i = 0; i < 4; ++i) {
                    u32x2 o2 = {cvtpk(v[q][i][0] * rs * wv[i][0], v[q][i][1] * rs * wv[i][1]), cvtpk(v[q][i][2] * rs * wv[i][2], v[q][i][3] * rs * wv[i][3])};
                    *(u32x2*)(dst + (size_t)m * DM + i * 256 + lane * 4) = o2;
                }
            }
        }
    }
}

__device__ const double kInvFreq[32] = {1.0, 0.7498942093324559, 0.5623413251903491, 0.4216965034285822, 0.31622776601683794, 0.23713737056616552, 0.1778279410038923, 0.1333521432163324, 0.1, 0.07498942093324558, 0.05623413251903491, 0.042169650342858224, 0.03162277660168379, 0.023713737056616554, 0.01778279410038923, 0.01333521432163324, 0.01, 0.007498942093324558, 0.005623413251903491, 0.004216965034285823, 0.0031622776601683794, 0.0023713737056616554, 0.0017782794100389228, 0.001333521432163324, 0.001, 0.0007498942093324559, 0.0005623413251903491, 0.00042169650342858224, 0.00031622776601683794, 0.00023713737056616554, 0.00017782794100389227, 0.0001333521432163324};

DI void phase0(const Params& p, char* lds) {
    char* ws = p.ws;
    const int nt0 = 16 * (INWP / 64), nt1 = 16 * 16, nt2 = 16 * (DFF2P / 64), nt3 = (DFFP / 64) * 16;
    for (int t = blockIdx.x; t < nt0 + nt1 + nt2 + nt3; t += gridDim.x) {
        if (t < nt0) transpose_w(p.w_in, 1024, INW, (bf16_t*)(ws + OFF_WIN), 1024, t, lds);
        else if (t < nt0 + nt1) transpose_w(p.w_out, 1024, 1024, (bf16_t*)(ws + OFF_WOUT), 1024, t - nt0, lds);
        else if (t < nt0 + nt1 + nt2) transpose_w(p.w_ffn_in, 1024, DFF2, (bf16_t*)(ws + OFF_WFFI), 1024, t - nt0 - nt1, lds, p.norm2_w);
        else transpose_w(p.w_ffn_out, DFF, 1024, (bf16_t*)(ws + OFF_WFFO), DFFP, t - nt0 - nt1 - nt2, lds);
    }
    if (blockIdx.x == 0 && threadIdx.x < 32) {
        const double w = kInvFreq[threadIdx.x], w2 = w * w;
        double sn = 0.0, cs = 0.0, ts = w, tc = 1.0;
        for (int k = 0; k < 12; ++k) { sn += ts; cs += tc; tc = -tc * w2 / ((2 * k + 1) * (2 * k + 2)); ts = -ts * w2 / ((2 * k + 2) * (2 * k + 3)); }
        double c = 1.0, s = 0.0; float* tab = (float*)(ws + OFF_ROPE);
        for (int pos = 0; pos < 256; ++pos) { tab[(pos * 32 + threadIdx.x) * 2] = (float)c; tab[(pos * 32 + threadIdx.x) * 2 + 1] = (float)s; double c2 = c * cs - s * sn, s2 = s * cs + c * sn; c = c2; s = s2; }
    }
    if (blockIdx.x == 0 && threadIdx.x == 64) { atomicExch((unsigned*)(ws + OFF_CTR), 0u); }
    for (int i = blockIdx.x * NTHR + threadIdx.x; i < M_TOK; i += gridDim.x * NTHR) ((float*)(ws + OFF_SS))[i] = 0.f;
    rmsnorm_rows(p, false, p.norm1_w, (bf16_t*)p.out);
}

namespace pg8 {
#define PG8_LAS __attribute__((address_space(3)))
constexpr int BM = 256, BK = 64, HALF = 128, HTB = HALF * BK * 2, STAGE_BYTES = 8 * HTB;
DI int lds_byte(int r, int c) { const int st = (r >> 4) * 2 + (c >> 5), rr = r & 15, cc = c & 31, ob = rr * 64 + cc * 2; return st * 1024 + (ob ^ (((ob >> 9) & 1) << 5)); }
DI void stage_rc(int b, int& R, int& C) { const int st = b / 1024, sb = b % 1024, swz = sb ^ (((sb >> 9) & 1) << 5); R = (st >> 1) * 16 + swz / 64; C = (st & 1) * 32 + (swz % 64) / 2; }
DI int perm32(int rho) { const int n = rho >> 4, i = rho & 15; return 8 * (i >> 2) + 4 * n + (i & 3); }
struct Unit { int pm, pn; };
struct Gemm { const bf16_t* A; const bf16_t* Bt; int M, N, K; };
struct XcdOrder {
    int nN, mpx, bpx, xcd, loc, total;
    DI void init(int mt_cnt, int nN_) { nN = nN_; mpx = mt_cnt / 8; bpx = gridDim.x / 8; xcd = blockIdx.x % 8; loc = blockIdx.x / 8; total = mpx * nN; }
    DI bool next(int i, Unit& u) const {
        const int j = loc + i * bpx; if (j >= total) return false;
        const int grp = j / (4 * nN), rem = j % (4 * nN);
        u.pm = xcd * mpx + grp * 4 + (rem & 3); u.pn = rem >> 2; return true;
    }
    DI void a_ready(const Unit&) const {}
    DI void done(const Unit&) const {}
};
template <class Epi, class Sched, bool ALIGN_EPI = false, bool SP2 = false>
__device__ __forceinline__ void gemm_phase(PG8_LAS unsigned char* lds, const Gemm g, const Sched& S, const Epi& E) {
    const int tid = threadIdx.x, wid = __builtin_amdgcn_readfirstlane(tid >> 6), lane = tid & 63, wr = wid >> 2, wc = wid & 3, fr = lane & 15, fq = lane >> 4;
    const int K = g.K, nt = K / BK;
    unsigned voffA[2], voffB[2];
#pragma unroll
    for (int i = 0; i < 2; ++i) { int R, C; stage_rc(tid * 16 + i * 8192, R, C); const int Rb = Epi::PERM ? ((R & ~31) + perm32(R & 31)) : R;
        voffA[i] = (unsigned)(R * K + C) * 2u; voffB[i] = (unsigned)(Rb * K + C) * 2u; }
    const size_t kstep = (size_t)(BK * 2);
    const size_t hstep = (size_t)HALF * K * 2;
    const size_t tstep = 2 * hstep;
    const unsigned ldsw = (unsigned)wid * 1024u;
    const int aoff = lds_byte(wr * 64 + fr, fq * 8), boff = lds_byte(wc * 32 + fr, fq * 8);
#define PG8_SA(b, h) (((b) * 2 + (h)) * HTB)
#define PG8_SB(b, h) ((4 + (b) * 2 + (h)) * HTB)
#define PG8_STAGE(bufoff, gbase, voff) do { _Pragma("unroll") for (int _i = 0; _i < 2; ++_i) \
        __builtin_amdgcn_global_load_lds((const unsigned*)((const char*)(gbase) + (voff)[_i]), (PG8_LAS unsigned*)(lds + (bufoff) + ldsw + _i * 8192), 16, 0, 0); } while (0)
#define PG8_LDA(dst, b, h) do { _Pragma("unroll") for (int m = 0; m < 4; ++m) _Pragma("unroll") for (int k = 0; k < 2; ++k) dst[m][k] = *(const PG8_LAS bf16x8*)(lds + PG8_SA(b, h) + aoff + m * 2048 + k * 1024); } while (0)
#define PG8_LDB(dst, b, h) do { _Pragma("unroll") for (int n = 0; n < 2; ++n) _Pragma("unroll") for (int k = 0; k < 2; ++k) dst[n][k] = *(const PG8_LAS bf16x8*)(lds + PG8_SB(b, h) + boff + n * 2048 + k * 1024); } while (0)
#define PG8_MMA(ai, bj, At, Bt) do { __builtin_amdgcn_s_setprio(1); _Pragma("unroll") for (int m = 0; m < 4; ++m) _Pragma("unroll") for (int n = 0; n < 2; ++n) _Pragma("unroll") for (int k = 0; k < 2; ++k) \
        acc[ai][bj][m][n] = __builtin_amdgcn_mfma_f32_16x16x32_bf16(Bt[n][k], At[m][k], acc[ai][bj][m][n], 0, 0, 0); __builtin_amdgcn_s_setprio(0); } while (0)
#define PG8_WAIT_V(n) asm volatile("s_waitcnt vmcnt(" #n ")" ::: "memory")
#define PG8_WAIT_L(n) asm volatile("s_waitcnt lgkmcnt(" #n ")" ::: "memory")
#define PG8_BAR __builtin_amdgcn_s_barrier()
#define PG8_SCHED __builtin_amdgcn_sched_barrier(0)
    Unit cur, nxt; int ui = 0;
    if (!S.next(0, cur)) return;
    f32x4 acc[2][2][4][2];
#pragma unroll
    for (int a = 0; a < 2; ++a)
#pragma unroll
        for (int b = 0; b < 2; ++b)
#pragma unroll
            for (int m = 0; m < 4; ++m)
#pragma unroll
                for (int n = 0; n < 2; ++n) acc[a][b][m][n] = (f32x4){0.f, 0.f, 0.f, 0.f};
    bf16x8 At[4][2], B0[2][2], B1[2][2];
    const char* cA = (const char*)g.A + (size_t)cur.pm * tstep; const char* cB = (const char*)g.Bt + (size_t)cur.pn * tstep;
    S.a_ready(cur);
    if constexpr (SP2) {
        PG8_STAGE(PG8_SB(0, 0), cB, voffB); PG8_STAGE(PG8_SB(0, 1), cB + hstep, voffB); PG8_STAGE(PG8_SA(0, 0), cA, voffA); PG8_STAGE(PG8_SA(0, 1), cA + hstep, voffA);
        if (wr == 1) PG8_BAR;
        PG8_WAIT_V(2); PG8_BAR;
        PG8_STAGE(PG8_SB(1, 0), cB + kstep, voffB); PG8_STAGE(PG8_SA(1, 0), cA + kstep, voffA); PG8_STAGE(PG8_SB(1, 1), cB + hstep + kstep, voffB);
        PG8_WAIT_V(6); PG8_BAR;
    } else {
        PG8_STAGE(PG8_SB(0, 0), cB, voffB); PG8_STAGE(PG8_SA(0, 0), cA, voffA); PG8_STAGE(PG8_SB(0, 1), cB + hstep, voffB); PG8_STAGE(PG8_SA(0, 1), cA + hstep, voffA);
        if (wr == 1) PG8_BAR;
        PG8_WAIT_V(4); PG8_BAR;
        PG8_STAGE(PG8_SB(1, 0), cB + kstep, voffB); PG8_STAGE(PG8_SA(1, 0), cA + kstep, voffA); PG8_STAGE(PG8_SB(1, 1), cB + hstep + kstep, voffB);
        PG8_WAIT_V(6); PG8_BAR;
    }
    for (;;) {
        const bool has_next = S.next(ui + 1, nxt);
        const char* nA = has_next ? (const char*)g.A + (size_t)nxt.pm * tstep : cA; const char* nB = has_next ? (const char*)g.Bt + (size_t)nxt.pn * tstep : cB;
        for (int t = 0; t < nt; t += 2) {
            const bool last = (t == nt - 2);
            const char* a1 = cA + (size_t)(t + 1) * kstep;
            const char* a2 = last ? nA : cA + (size_t)(t + 2) * kstep; const char* b2 = last ? nB : cB + (size_t)(t + 2) * kstep;
            const char* a3 = a2 + kstep; const char* b3 = b2 + kstep;
            if (last && has_next) S.a_ready(nxt);
            if constexpr (SP2) {
            PG8_LDB(B0, 0, 0); PG8_LDB(B1, 0, 1); PG8_SCHED; PG8_LDA(At, 0, 0); PG8_STAGE(PG8_SA(1, 1), a1 + hstep, voffA);
            PG8_WAIT_V(8); PG8_WAIT_L(0); PG8_BAR; PG8_MMA(0, 0, At, B0); PG8_MMA(0, 1, At, B1); PG8_BAR; PG8_SCHED;
            PG8_LDA(At, 0, 1); PG8_STAGE(PG8_SB(0, 0), b2, voffB); PG8_STAGE(PG8_SB(0, 1), b2 + hstep, voffB); PG8_STAGE(PG8_SA(0, 0), a2, voffA);
            PG8_WAIT_V(8); PG8_WAIT_L(0); PG8_BAR; PG8_MMA(1, 0, At, B0); PG8_MMA(1, 1, At, B1); PG8_BAR; PG8_SCHED;
            PG8_LDB(B0, 1, 0); PG8_LDB(B1, 1, 1); PG8_SCHED; PG8_LDA(At, 1, 0); PG8_STAGE(PG8_SA(0, 1), a2 + hstep, voffA);
            PG8_WAIT_V(8); PG8_WAIT_L(0); PG8_BAR; PG8_MMA(0, 0, At, B0); PG8_MMA(0, 1, At, B1); PG8_BAR; PG8_SCHED;
            PG8_LDA(At, 1, 1); PG8_STAGE(PG8_SB(1, 0), b3, voffB); PG8_STAGE(PG8_SB(1, 1), b3 + hstep, voffB); PG8_STAGE(PG8_SA(1, 0), a3, voffA);
            PG8_WAIT_V(8); PG8_WAIT_L(0); PG8_BAR; PG8_MMA(1, 0, At, B0); PG8_MMA(1, 1, At, B1); PG8_BAR; PG8_SCHED;
            } else {
            PG8_LDB(B0, 0, 0); PG8_SCHED; PG8_LDA(At, 0, 0); PG8_STAGE(PG8_SA(1, 1), a1 + hstep, voffA);
            PG8_WAIT_L(8); PG8_BAR; PG8_WAIT_L(0); PG8_MMA(0, 0, At, B0); PG8_BAR; PG8_SCHED;
            PG8_LDB(B1, 0, 1); PG8_STAGE(PG8_SB(0, 0), b2, voffB);
            PG8_BAR; PG8_WAIT_L(0); PG8_MMA(0, 1, At, B1); PG8_BAR;
            PG8_LDA(At, 0, 1); PG8_STAGE(PG8_SA(0, 0), a2, voffA);
            PG8_BAR; PG8_WAIT_L(0); PG8_MMA(1, 0, At, B0); PG8_BAR; PG8_SCHED;
            PG8_STAGE(PG8_SB(0, 1), b2 + hstep, voffB);
            PG8_WAIT_V(6); PG8_BAR; PG8_MMA(1, 1, At, B1); PG8_BAR;
            PG8_LDB(B0, 1, 0); PG8_SCHED; PG8_LDA(At, 1, 0); PG8_STAGE(PG8_SA(0, 1), a2 + hstep, voffA);
            PG8_WAIT_L(8); PG8_BAR; PG8_WAIT_L(0); PG8_MMA(0, 0, At, B0); PG8_BAR; PG8_SCHED;
            PG8_LDB(B1, 1, 1); PG8_STAGE(PG8_SB(1, 0), b3, voffB);
            PG8_BAR; PG8_WAIT_L(0); PG8_MMA(0, 1, At, B1); PG8_BAR;
            PG8_LDA(At, 1, 1); PG8_STAGE(PG8_SA(1, 0), a3, voffA);
            PG8_BAR; PG8_WAIT_L(0); PG8_MMA(1, 0, At, B0); PG8_BAR; PG8_SCHED;
            PG8_STAGE(PG8_SB(1, 1), b3 + hstep, voffB);
            PG8_WAIT_V(6); PG8_BAR; PG8_MMA(1, 1, At, B1); PG8_BAR;
            }
        }
        if constexpr (ALIGN_EPI) { if (wr == 0) PG8_BAR; }
        if constexpr (!Epi::AFTER_DRAIN) { E(acc, cur, wr, wc, fr, fq); S.done(cur); }
        if (!has_next) break;
#pragma unroll
        for (int a = 0; a < 2; ++a)
#pragma unroll
            for (int b = 0; b < 2; ++b)
#pragma unroll
                for (int m = 0; m < 4; ++m)
#pragma unroll
                    for (int n = 0; n < 2; ++n) acc[a][b][m][n] = (f32x4){0.f, 0.f, 0.f, 0.f};
        cur = nxt; cA = nA; cB = nB; ++ui;
        if constexpr (ALIGN_EPI) { if (wr == 1) PG8_BAR; }
    }
    PG8_WAIT_V(0);
    if constexpr (!ALIGN_EPI) { if (wr == 0) PG8_BAR; }
    PG8_BAR;
    if constexpr (Epi::AFTER_DRAIN) { E.fused(acc, cur, wr, wc, fr, fq, lds, wid, lane); S.done(cur); }
#undef PG8_SA
#undef PG8_SB
#undef PG8_STAGE
#undef PG8_LDA
#undef PG8_LDB
#undef PG8_MMA
#undef PG8_WAIT_V
#undef PG8_WAIT_L
#undef PG8_BAR
#undef PG8_SCHED
}

template <class F> struct EpiRows {
    static constexpr bool PERM = true, AFTER_DRAIN = false;
    F f;
    DI void operator()(const f32x4 (&acc)[2][2][4][2], const Unit& u, int wr, int wc, int fr, int fq) const {
#pragma unroll
        for (int ai = 0; ai < 2; ++ai)
#pragma unroll
            for (int m = 0; m < 4; ++m) {
                const int r = u.pm * BM + ai * HALF + wr * 64 + m * 16 + fr;
#pragma unroll
                for (int bj = 0; bj < 2; ++bj) f(r, u.pn * BM + bj * HALF + wc * 32 + 8 * fq, acc[ai][bj][m][0], acc[ai][bj][m][1]);
                asm volatile("" ::: "memory");
            }
    }
};
}

DI void st_bf8(bf16_t* p, f32x4 a, f32x4 b) { u32x4 o = {cvtpk(a[0], a[1]), cvtpk(a[2], a[3]), cvtpk(b[0], b[1]), cvtpk(b[2], b[3])}; *(u32x4*)p = o; }

struct FInProj { bf16_t* bufA; bf16_t* projD; bf16_t* bufZ; float* gates;
    DI void operator()(int m, int n0, f32x4 a, f32x4 b) const {
        if (n0 < 1024) st_bf8(bufA + (size_t)m * 1024 + n0, a, b);
        else if (n0 < 2560) st_bf8(projD + (size_t)m * 1536 + (n0 - 1024), a, b);
        else if (n0 < 3072) st_bf8(bufZ + (size_t)m * 512 + (n0 - 2560), a, b);
        else if (n0 < 3088) { float* g = gates + (size_t)m * 16 + (n0 - 3072); *(f32x4*)g = a; *(f32x4*)(g + 4) = b; }
    } };
struct FResX { const float* xp; const float* xs; float* out;
    DI void operator()(int m, int n0, f32x4 a, f32x4 b) const {
        const float* xr = (m < MP ? xp + (size_t)m * DM : xs + (size_t)(m - MP) * DM) + n0;
        const f32x4 r0 = *(const f32x4*)xr, r1 = *(const f32x4*)(xr + 4);
        float* o = out + (size_t)m * DM + n0; *(f32x4*)o = r0 + a; *(f32x4*)(o + 4) = r1 + b;
    } };
struct FU { bf16_t* us; const float* ss;
    DI void operator()(int m, int n0, f32x4 a, f32x4 b) const { if (n0 < DFF2) { const float rs = rsqrtf(ss[m] * (1.f / 1024.f) + 1e-6f); st_bf8(us + (size_t)m * DFF2 + n0, a * rs, b * rs); } } };
struct FResOut { float* out;
    DI void operator()(int m, int n0, f32x4 a, f32x4 b) const { float* o = out + (size_t)m * DM + n0; const f32x4 r0 = *(const f32x4*)o, r1 = *(const f32x4*)(o + 4); *(f32x4*)o = r0 + a; *(f32x4*)(o + 4) = r1 + b; } };

struct EpiOutProj {
    static constexpr bool PERM = true, AFTER_DRAIN = false;
    const float* xp; const float* xs; float* out; bf16_t* xb; float* ss;
    DI void operator()(const f32x4 (&acc)[2][2][4][2], const pg8::Unit& u, int wr, int wc, int fr, int fq) const {
#pragma unroll
        for (int ai = 0; ai < 2; ++ai)
#pragma unroll
            for (int m = 0; m < 4; ++m) {
                const int r = u.pm * 256 + ai * 128 + wr * 64 + m * 16 + fr;
                const float* xr = (r < MP ? xp + (size_t)r * DM : xs + (size_t)(r - MP) * DM);
                float part = 0.f;
#pragma unroll
                for (int bj = 0; bj < 2; ++bj) {
                    const int n0 = u.pn * 256 + bj * 128 + wc * 32 + 8 * fq;
                    const f32x4 v0 = *(const f32x4*)(xr + n0) + acc[ai][bj][m][0], v1 = *(const f32x4*)(xr + n0 + 4) + acc[ai][bj][m][1];
                    float* o = out + (size_t)r * DM + n0; *(f32x4*)o = v0; *(f32x4*)(o + 4) = v1;
                    st_bf8(xb + (size_t)r * DM + n0, v0, v1);
                    part += (v0[0] * v0[0] + v0[1] * v0[1]) + (v0[2] * v0[2] + v0[3] * v0[3]) + (v1[0] * v1[0] + v1[1] * v1[1]) + (v1[2] * v1[2] + v1[3] * v1[3]);
                }
                part += __shfl_xor(part, 16); part += __shfl_xor(part, 32);
                if (fq == 0) atomicAdd(ss + r, part);
                asm volatile("" ::: "memory");
            }
    }
};

template <class F> DI void run_gemm(char* lds, const bf16_t* A, const bf16_t* Bt, int K, int mt_cnt, int nN, const F& f) {
    pg8::Gemm g{A, Bt, mt_cnt * 256, nN * 256, K};
    pg8::XcdOrder S; S.init(mt_cnt, nN);
    pg8::EpiRows<F> E{f};
    pg8::gemm_phase<pg8::EpiRows<F>, pg8::XcdOrder, true, true>((PG8_LAS unsigned char*)lds, g, S, E);
}

constexpr float ASCALE = 0.088388347648318440f;
constexpr float ATHR2 = 8.f * 1.4426950408889634f;
DI void phase_attn_prep(const Params& p) {
    bf16_t* bufA = (bf16_t*)((char*)p.out + 2 * U1);
    const float* tab = (const float*)(p.ws + OFF_ROPE);
    const int j = threadIdx.x & 7;
    const int gid = (blockIdx.x * NTHR + threadIdx.x) >> 3, ng = (gridDim.x * NTHR) >> 3;
    float wq[16], wk[16];
#pragma unroll
    for (int qd_ = 0; qd_ < 4; ++qd_)
#pragma unroll
        for (int e = 0; e < 4; ++e) { wq[qd_ * 4 + e] = p.q_norm_w[qd_ * 32 + 4 * j + e]; wk[qd_ * 4 + e] = p.k_norm_w[qd_ * 32 + 4 * j + e]; }
    for (int u0 = gid; u0 < M_TOK * 6; u0 += 2 * ng) {
        u32x2 raw[2][4]; bool ok[2];
#pragma unroll
        for (int q = 0; q < 2; ++q) {
            const int u = u0 + q * ng; ok[q] = u < M_TOK * 6;
            const int uu = ok[q] ? u : 0; const int m = uu / 6, slot = uu - m * 6;
            const bf16_t* ptr = bufA + (size_t)m * 1024 + slot * 128 + 4 * j;
#pragma unroll
            for (int qd_ = 0; qd_ < 4; ++qd_) raw[q][qd_] = *(const u32x2*)(ptr + 32 * qd_);
        }
#pragma unroll
        for (int q = 0; q < 2; ++q) {
            const int u = u0 + q * ng; const int uu = ok[q] ? u : 0; const int m = uu / 6, slot = uu - m * 6;
            int base, t, T; seq_of(m, base, t, T);
            float v[16]; float ss = 0.f;
#pragma unroll
            for (int qd_ = 0; qd_ < 4; ++qd_) { v[qd_ * 4] = bflo(raw[q][qd_].x); v[qd_ * 4 + 1] = bfhi(raw[q][qd_].x); v[qd_ * 4 + 2] = bflo(raw[q][qd_].y); v[qd_ * 4 + 3] = bfhi(raw[q][qd_].y); }
#pragma unroll
            for (int e = 0; e < 16; ++e) ss += v[e] * v[e];
#pragma unroll
            for (int o = 4; o >= 1; o >>= 1) ss += __shfl_xor(ss, o);
            const float rs = rsqrtf(ss * (1.f / 128.f) + 1e-6f);
            const float rsq = slot < 4 ? rs * (ASCALE * 1.4426950408889634f) : rs;
#pragma unroll
            for (int e = 0; e < 16; ++e) v[e] = v[e] * rsq * (slot < 4 ? wq[e] : wk[e]);
            const int pr = t >> 6, pc = t & 63;
            const f32x4* tr = (const f32x4*)(tab + (pr * 32 + 4 * j) * 2); const f32x4* tc = (const f32x4*)(tab + (pc * 32 + 4 * j) * 2);
            const f32x4 r0 = tr[0], r1 = tr[1], c0 = tc[0], c1 = tc[1];
            const float cr[4] = {r0[0], r0[2], r1[0], r1[2]}, sr[4] = {r0[1], r0[3], r1[1], r1[3]};
            const float cc[4] = {c0[0], c0[2], c1[0], c1[2]}, sc[4] = {c0[1], c0[3], c1[1], c1[3]};
            float o[16];
#pragma unroll
            for (int e = 0; e < 4; ++e) {
                o[e] = v[e] * cr[e] - v[4 + e] * sr[e]; o[4 + e] = v[4 + e] * cr[e] + v[e] * sr[e];
                o[8 + e] = v[8 + e] * cc[e] - v[12 + e] * sc[e]; o[12 + e] = v[12 + e] * cc[e] + v[8 + e] * sc[e];
            }
            if (ok[q]) {
                bf16_t* ptr = bufA + (size_t)m * 1024 + slot * 128 + 4 * j;
#pragma unroll
                for (int qd_ = 0; qd_ < 4; ++qd_) *(u32x2*)(ptr + 32 * qd_) = (u32x2){cvtpk(o[qd_ * 4], o[qd_ * 4 + 1]), cvtpk(o[qd_ * 4 + 2], o[qd_ * 4 + 3])};
            }
        }
    }
}

constexpr int PL_QB = 0, PL_KB = 16896, PL_VT = 33792, PL_KT = 52224, PL_GKK = 70656, PL_LF = 70656, PL_GQK = 87040, PL_LB = 103424, PL_T = 119808, PL_SM = 156672;

template <int PI> DI void tsolve_row(float (&x)[64], const float* L, int j, f32x4 (&lc)[8], f32x4 (&ln)[8]) {
    f32x4 lh[8];
#pragma unroll
    for (int s4 = 8; s4 < (PI + 3) / 4; ++s4) lh[s4 - 8] = *(const f32x4*)(L + PI * 64 + 4 * s4);
    if (PI + 1 < 64) {
#pragma unroll
        for (int s4 = 0; s4 < (PI + 4) / 4 && s4 < 8; ++s4) ln[s4] = *(const f32x4*)(L + (PI + 1) * 64 + 4 * s4);
    }
    asm volatile("" ::: "memory");
    float a[4] = {(PI == j) ? 1.f : 0.f, 0.f, 0.f, 0.f};
#pragma unroll
    for (int s4 = 0; s4 < (PI + 3) / 4 && s4 < 8; ++s4) {
#pragma unroll
        for (int k = 0; k < 4; ++k) if (4 * s4 + k < PI) a[k] -= lc[s4][k] * x[4 * s4 + k];
    }
#pragma unroll
    for (int s4 = 8; s4 < (PI + 3) / 4; ++s4) {
#pragma unroll
        for (int k = 0; k < 4; ++k) if (4 * s4 + k < PI) a[k] -= lh[s4 - 8][k] * x[4 * s4 + k];
    }
    x[PI] = (a[0] + a[1]) + (a[2] + a[3]);
}
template <int PI> DI void tsolve_pair(float (&x)[64], const float* L, int j, f32x4 (&la)[8], f32x4 (&lb)[8]) {
    tsolve_row<2 * PI>(x, L, j, la, lb);
    tsolve_row<2 * PI + 1>(x, L, j, lb, la);
}
template <int... Is> DI void tsolve_all(float (&x)[64], const float* L, int j, std::integer_sequence<int, Is...>) {
    f32x4 la[8], lb[8];
    (tsolve_pair<Is>(x, L, j, la, lb), ...);
}
template <int... Is> DI void tstore_all(const float (&x)[64], char* TU, char* TW, float mu, float mw, std::integer_sequence<int, Is...>) {
    ((*(bf16_t*)(TU + Is * 144) = f2bf(x[Is] * mu), *(bf16_t*)(TW + Is * 144) = f2bf(x[Is] * mw)), ...);
}

DI void dn_prep_load(const Params& p, int gchunk, int h, u32x2 (&xr)[20]) {
    int tid = threadIdx.x; asm volatile("" : "+v"(tid));
    if (tid < 384) {
        const bf16_t* projD = (const bf16_t*)(p.ws + OFF_PROJD);
        const int c4 = tid & 31, grp = tid >> 5, seg = grp >> 2, tq = grp & 3;
        const int ch = seg * 512 + h * 128 + c4 * 4;
        int base, t0, T; seq_of(gchunk * 64, base, t0, T);
#pragma unroll
        for (int r = 0; r < 20; ++r) {
            const int t = t0 + tq * 16 + r - 2;
            if (t >= 0 && t < T) xr[r] = *(const u32x2*)(projD + (size_t)(base + t) * 1536 + ch);
            else xr[r] = (u32x2){0u, 0u};
        }
    }
}

DI void dn_prep_unit(const Params& p, int gchunk, int h, char* lds, u32x2 (&xr)[20], int gchunk_n, int h_n) {
    int tid_ = threadIdx.x; asm volatile("" : "+v"(tid_));
    const int tid = tid_, wid = tid >> 6, lane = tid & 63, r32 = lane & 31, hh = lane >> 5;
    char* ws = p.ws;
    const float* gates = (const float*)(ws + OFF_GATES);
    bf16_t* qd = (bf16_t*)p.out; bf16_t* kd = (bf16_t*)((char*)p.out + U1);
    const int m0 = gchunk * 64;
    int base, t0, T; seq_of(m0, base, t0, T);
    float* Gkk = (float*)(lds + PL_GKK); float* Gqk = (float*)(lds + PL_GQK);
    float* sm = (float*)(lds + PL_SM);
    __syncthreads();
#ifndef SKIP_CONV
    if (tid < 384) {
        const int c4 = tid & 31, grp = tid >> 5, seg = grp >> 2, tq = grp & 3;
        const int ch = seg * 512 + h * 128 + c4 * 4;
        f32x4 w[5];
#pragma unroll
        for (int j = 0; j < 5; ++j) w[j] = *(const f32x4*)(p.dn_conv_w + j * 1536 + ch);
        f32x4 x[20];
#pragma unroll
        for (int r = 0; r < 20; ++r) x[r] = (f32x4){bflo(xr[r].x), bfhi(xr[r].x), bflo(xr[r].y), bfhi(xr[r].y)};
        unsigned tp[4][8];
#pragma unroll
        for (int i = 0; i < 16; i += 2) {
            f32x4 yy[2];
#pragma unroll
            for (int ii = 0; ii < 2; ++ii) {
                f32x4 a = x[i + ii] * w[0];
#pragma unroll
                for (int j = 1; j < 5; ++j) a += x[i + ii + j] * w[j];
                f32x4 y = {silu_f(a[0]), silu_f(a[1]), silu_f(a[2]), silu_f(a[3])};
                const int tl = tq * 16 + i + ii;
                if (seg < 2) {
                    float ss = y[0] * y[0] + y[1] * y[1] + y[2] * y[2] + y[3] * y[3];
#pragma unroll
                    for (int o = 16; o >= 1; o >>= 1) ss += __shfl_xor(ss, o);
                    float sc = rsqrtf(ss + 1e-6f); if (seg == 0) sc *= 0.08838834764831845f;
                    y = y * sc;
                    u32x2 o2 = {cvtpk(y[0], y[1]), cvtpk(y[2], y[3])};
                    *(u32x2*)(lds + (seg == 0 ? PL_QB : PL_KB) + tl * 264 + c4 * 8) = o2;
                    *(u32x2*)((seg == 0 ? qd : kd) + (size_t)(m0 + tl) * 512 + h * 128 + c4 * 4) = o2;
                }
                yy[ii] = y;
            }
#pragma unroll
            for (int e = 0; e < 4; ++e) tp[e][i >> 1] = cvtpk(yy[0][e], yy[1][e]);
        }
        if (seg >= 1) {
            char* dstT = lds + (seg == 1 ? PL_KT : PL_VT);
#pragma unroll
            for (int e = 0; e < 4; ++e) {
                char* d = dstT + (c4 * 4 + e) * 144 + tq * 32;
                *(u32x4*)d = (u32x4){tp[e][0], tp[e][1], tp[e][2], tp[e][3]};
                *(u32x4*)(d + 16) = (u32x4){tp[e][4], tp[e][5], tp[e][6], tp[e][7]};
            }
        }
    } else
#endif
    if (tid >= 384 && tid < 512) {
        const int dir = wid - 6, pidx = lane, tl = dir ? 63 - pidx : pidx;
        const float a = gates[(size_t)(m0 + tl) * 16 + dir * 4 + h], b = gates[(size_t)(m0 + tl) * 16 + 8 + dir * 4 + h];
        const float Al = dir ? p.A_log_b[h] : p.A_log_f[h], db = dir ? p.dt_b[h] : p.dt_f[h];
        const float xx = a + db; const float sp = xx > 20.f ? xx : log1pf(expf(xx));
        float g = -expf(Al) * sp; const float beta = 1.f / (1.f + expf(-b));
#pragma unroll
        for (int o = 1; o < 64; o <<= 1) { float n = __shfl_up(g, o); if (lane >= o) g += n; }
        sm[dir * 64 + pidx] = beta; sm[128 + dir * 64 + pidx] = g; sm[256 + dir * 64 + pidx] = beta; sm[384 + dir * 64 + pidx] = beta * __expf(g);
        ((float*)(ws + OFF_GC))[((size_t)(gchunk * 4 + h) * 2 + dir) * 64 + pidx] = g;
    }
    __syncthreads();
    if (gchunk_n >= 0) dn_prep_load(p, gchunk_n, h_n, xr);
    {
        const int mat = wid >> 2, ti = (wid >> 1) & 1, tj = wid & 1;
        const char* X = lds + (mat ? PL_QB : PL_KB); const char* Kb = lds + PL_KB;
        f32x16 acc;
#pragma unroll
        for (int i = 0; i < 16; ++i) acc[i] = 0.f;
#pragma unroll
        for (int ks = 0; ks < 8; ++ks) {
            const int off = (ks * 16 + hh * 8) * 2;
            bf16x8 a = ld2x64(X + (ti * 32 + r32) * 264 + off, X + (ti * 32 + r32) * 264 + off + 8);
            bf16x8 b = ld2x64(Kb + (tj * 32 + r32) * 264 + off, Kb + (tj * 32 + r32) * 264 + off + 8);
            acc = MFMA32(a, b, acc);
        }
        float* G = mat ? Gqk : Gkk;
#pragma unroll
        for (int i = 0; i < 16; ++i) G[(ti * 32 + crow(i, hh)) * 64 + tj * 32 + r32] = acc[i];
    }
    __syncthreads();
    {
        const int dir = tid >> 8, q = tid & 255, si = q & 63, p0 = (q >> 6) * 16;
        const float* beta = sm + dir * 64; const float* gc = sm + 128 + dir * 64;
        float* L = (float*)(lds + (dir ? PL_LB : PL_LF));
        bf16_t* Ac = (bf16_t*)(ws + OFF_AC) + ((size_t)(gchunk * 4 + h) * 2 + dir) * 4096;
        const int sx = dir ? 63 - si : si; const float gs = gc[si];
        float gk[16], gq[16];
#pragma unroll
        for (int k = 0; k < 16; ++k) { const int pi = p0 + k, c = dir ? 63 - pi : pi; gk[k] = Gkk[c * 64 + sx]; gq[k] = Gqk[c * 64 + sx]; }
        __syncthreads();
#pragma unroll
        for (int k = 0; k < 16; ++k) {
            const int pi = p0 + k;
            const float dec = (si <= pi) ? __expf(gc[pi] - gs) : 0.f;
            L[pi * 64 + si] = (si < pi) ? beta[pi] * gk[k] * dec : 0.f;
            Ac[pi * 64 + si] = f2bf(gq[k] * dec);
        }
    }
    __syncthreads();
    if (tid < 128) {
        const int dir = tid >> 6, j = tid & 63;
        const float* L = (const float*)(lds + (dir ? PL_LB : PL_LF));
        float x[64];
        tsolve_all(x, L, j, std::make_integer_sequence<int, 32>{});
        const int kpos = dir ? 63 - j : j;
        char* TU = lds + PL_T + (dir * 2) * 9216 + kpos * 2; char* TW = TU + 9216;
        tstore_all(x, TU, TW, sm[256 + dir * 64 + j], sm[384 + dir * 64 + j], std::make_integer_sequence<int, 64>{});
    }
    __syncthreads();
    {
        const int dir = wid >> 2, which = (wid >> 1) & 1, half = wid & 1;
        const char* Ta = lds + PL_T + (dir * 2 + which) * 9216;
        const char* Bm = lds + (which ? PL_KT : PL_VT);
        const size_t ci = (size_t)(gchunk * 4 + h) * 2 + dir;
        f32x16 acc[2][2];
#pragma unroll
        for (int a = 0; a < 2; ++a)
#pragma unroll
            for (int b = 0; b < 2; ++b)
#pragma unroll
                for (int i = 0; i < 16; ++i) acc[a][b][i] = 0.f;
#pragma unroll
        for (int ks = 0; ks < 4; ++ks) {
            const int ko = (ks * 16 + hh * 8) * 2;
            bf16x8 af[2], bfr[2];
#pragma unroll
            for (int pt = 0; pt < 2; ++pt) af[pt] = *(const bf16x8*)(Ta + (pt * 32 + r32) * 144 + ko);
#pragma unroll
            for (int ct = 0; ct < 2; ++ct) bfr[ct] = *(const bf16x8*)(Bm + (half * 64 + ct * 32 + r32) * 144 + ko);
#pragma unroll
            for (int pt = 0; pt < 2; ++pt)
#pragma unroll
                for (int ct = 0; ct < 2; ++ct) acc[pt][ct] = MFMA32(af[pt], bfr[ct], acc[pt][ct]);
        }
        if (which == 0) {
            bf16_t* Uc = (bf16_t*)(ws + OFF_UC) + ci * 8192;
#pragma unroll
            for (int pt = 0; pt < 2; ++pt)
#pragma unroll
                for (int ct = 0; ct < 2; ++ct) {
                    const f32x16& a = acc[pt][ct];
                    u32x4* d = (u32x4*)(Uc + (((half * 2 + ct) * 2 + pt) * 64 + lane) * 16);
                    d[0] = (u32x4){cvtpk(a[0], a[1]), cvtpk(a[2], a[3]), cvtpk(a[4], a[5]), cvtpk(a[6], a[7])};
                    d[1] = (u32x4){cvtpk(a[8], a[9]), cvtpk(a[10], a[11]), cvtpk(a[12], a[13]), cvtpk(a[14], a[15])};
                }
        } else {
            bf16_t* Wc = (bf16_t*)(ws + OFF_WC) + ci * 8192;
#pragma unroll
            for (int pt = 0; pt < 2; ++pt)
#pragma unroll
                for (int ct = 0; ct < 2; ++ct)
#pragma unroll
                    for (int i = 0; i < 16; ++i) Wc[(pt * 32 + crow(i, hh)) * 128 + half * 64 + ct * 32 + r32] = f2bf(-acc[pt][ct][i]);
        }
    }
}

constexpr int SL_W = 0, SL_QG = 16896, SL_KDT = 33792, SL_AT = 51200, SL_BUF = 59904;

DI void dn_scan_item(const Params& p, int seqbase, int T, int h, int dir, char* lds) {
    int tid_ = threadIdx.x; asm volatile("" : "+v"(tid_));
    const int tid = tid_, wid = __builtin_amdgcn_readfirstlane(tid >> 6), lane0 = tid & 63;
    char* ws = p.ws;
    const int N = T >> 6, gch0 = seqbase >> 6;
    const bf16_t* qd = (const bf16_t*)p.out; const bf16_t* kd = (const bf16_t*)((char*)p.out + U1);
    const bf16_t* WcB = (const bf16_t*)(ws + OFF_WC); const bf16_t* UcB = (const bf16_t*)(ws + OFF_UC);
    const bf16_t* AcB = (const bf16_t*)(ws + OFF_AC); const float* GcB = (const float*)(ws + OFF_GC);
    bf16_t* Oout = (bf16_t*)(ws + (dir ? OFF_OB : OFF_OF));
    const bool loader = wid >= 4;
    const int lt0 = tid - 256;

    struct LRegs { u32x4 rw[4], rq[4], rk[4], rat[2]; float gq[4]; float glast; };
    auto issue = [&](int n, LRegs& R) {
        int lt = lt0; asm volatile("" : "+v"(lt));
        const int cn = dir ? N - 1 - n : n; const int gchunk = gch0 + cn;
        const size_t ci = (size_t)(gchunk * 4 + h) * 2 + dir;
        const bf16_t* Wc = WcB + ci * 8192; const bf16_t* Ac = AcB + ci * 4096; const float* gc = GcB + ci * 64;
        R.glast = gc[63];
#pragma unroll
        for (int i = 0; i < 4; ++i) {
            const int q = lt + 256 * i, row = q >> 4, c16 = q & 15;
            const int tl = dir ? 63 - row : row; const size_t m = (size_t)gchunk * 64 + tl;
            R.rw[i] = *(const u32x4*)(Wc + row * 128 + c16 * 8);
            R.rq[i] = *(const u32x4*)(qd + m * 512 + h * 128 + c16 * 8);
            R.rk[i] = *(const u32x4*)(kd + m * 512 + h * 128 + c16 * 8);
            R.gq[i] = gc[row];
        }
#pragma unroll
        for (int i = 0; i < 2; ++i) { const int q = lt + 256 * i, row = q >> 3, c16 = q & 7; R.rat[i] = *(const u32x4*)(Ac + row * 64 + c16 * 8); }
    };
    auto commit = [&](int par, const LRegs& R) {
        int lt = lt0; asm volatile("" : "+v"(lt));
        char* buf = lds + par * SL_BUF;
#pragma unroll
        for (int i = 0; i < 4; ++i) {
            const int q = lt + 256 * i, row = q >> 4, c16 = q & 15;
            char* wd = buf + SL_W + row * 264 + c16 * 16;
            *(u32x2*)wd = (u32x2){R.rw[i].x, R.rw[i].y}; *(u32x2*)(wd + 8) = (u32x2){R.rw[i].z, R.rw[i].w};
            const float eq = __expf(R.gq[i]), ek = __expf(R.glast - R.gq[i]);
            unsigned qq[4] = {R.rq[i].x, R.rq[i].y, R.rq[i].z, R.rq[i].w}, kk[4] = {R.rk[i].x, R.rk[i].y, R.rk[i].z, R.rk[i].w};
            unsigned qo[4];
#pragma unroll
            for (int e = 0; e < 4; ++e) qo[e] = cvtpk(bflo(qq[e]) * eq, bfhi(qq[e]) * eq);
            char* qdst = buf + SL_QG + row * 264 + c16 * 16;
            *(u32x2*)qdst = (u32x2){qo[0], qo[1]}; *(u32x2*)(qdst + 8) = (u32x2){qo[2], qo[3]};
#pragma unroll
            for (int e = 0; e < 4; ++e) {
                const unsigned pk = cvtpk(bflo(kk[e]) * ek, bfhi(kk[e]) * ek);
                *(bf16_t*)(buf + SL_KDT + (c16 * 8 + 2 * e) * 136 + row * 2) = (bf16_t)(pk & 0xffffu);
                *(bf16_t*)(buf + SL_KDT + (c16 * 8 + 2 * e + 1) * 136 + row * 2) = (bf16_t)(pk >> 16);
            }
        }
#pragma unroll
        for (int i = 0; i < 2; ++i) {
            const int q = lt + 256 * i, row = q >> 3, c16 = q & 7;
            char* ad = buf + SL_AT + row * 136 + c16 * 16;
            *(u32x2*)ad = (u32x2){R.rat[i].x, R.rat[i].y}; *(u32x2*)(ad + 8) = (u32x2){R.rat[i].z, R.rat[i].w};
        }
    };

    f32x16 S[4];
#pragma unroll
    for (int d = 0; d < 4; ++d)
#pragma unroll
        for (int i = 0; i < 16; ++i) S[d][i] = 0.f;
    const int slab = wid & 3;
    struct URegs { u32x4 un[2][2]; float gl; };
    auto uload = [&](int n, URegs& U) {
        int lane = lane0; asm volatile("" : "+v"(lane));
        const int cn = dir ? N - 1 - n : n; const size_t ci = (size_t)((gch0 + cn) * 4 + h) * 2 + dir;
        const bf16_t* Uc = UcB + ci * 8192;
#pragma unroll
        for (int pt = 0; pt < 2; ++pt) { const u32x4* sp = (const u32x4*)(Uc + ((slab * 2 + pt) * 64 + lane) * 16); U.un[pt][0] = sp[0]; U.un[pt][1] = sp[1]; }
        U.gl = GcB[ci * 64 + 63];
    };
    auto compute = [&](int n, int par, URegs& U) {
        int lane = lane0; asm volatile("" : "+v"(lane));
        const int r32 = lane & 31, hh = lane >> 5;
        const char* buf = lds + par * SL_BUF;
        f32x16 vn[2], o[2];
#pragma unroll
        for (int pt = 0; pt < 2; ++pt) {
            const unsigned uu[8] = {U.un[pt][0].x, U.un[pt][0].y, U.un[pt][0].z, U.un[pt][0].w, U.un[pt][1].x, U.un[pt][1].y, U.un[pt][1].z, U.un[pt][1].w};
#pragma unroll
            for (int e = 0; e < 8; ++e) { vn[pt][2 * e] = bflo(uu[e]); vn[pt][2 * e + 1] = bfhi(uu[e]); }
#pragma unroll
            for (int i = 0; i < 16; ++i) o[pt][i] = 0.f;
        }
        const float gl = __expf(U.gl);
        if (n + 2 < N) uload(n + 2, U);
#pragma unroll
        for (int ks = 0; ks < 8; ++ks) {
            const bf16x8 sb = pack8(S[ks >> 1], ks & 1);
            const int off = (ks * 16 + 4 * hh) * 2;
#pragma unroll
            for (int pt = 0; pt < 2; ++pt) {
                const char* wr = buf + SL_W + (pt * 32 + r32) * 264 + off;
                const char* qr = buf + SL_QG + (pt * 32 + r32) * 264 + off;
                vn[pt] = MFMA32(ld2x64(wr, wr + 16), sb, vn[pt]);
                o[pt] = MFMA32(ld2x64(qr, qr + 16), sb, o[pt]);
            }
        }
        bf16x8 vb[4];
#pragma unroll
        for (int kp = 0; kp < 4; ++kp) vb[kp] = pack8(vn[kp >> 1], kp & 1);
#pragma unroll
        for (int d = 0; d < 4; ++d) S[d] = S[d] * gl;
#pragma unroll
        for (int kp = 0; kp < 4; ++kp) {
            const int off = (kp * 16 + 4 * hh) * 2;
#pragma unroll
            for (int pt = 0; pt < 2; ++pt) { const char* ar = buf + SL_AT + (pt * 32 + r32) * 136 + off; o[pt] = MFMA32(ld2x64(ar, ar + 16), vb[kp], o[pt]); }
#pragma unroll
            for (int d = 0; d < 4; ++d) { const char* kr = buf + SL_KDT + (d * 32 + r32) * 136 + off; S[d] = MFMA32(ld2x64(kr, kr + 16), vb[kp], S[d]); }
        }
        const int cn = dir ? N - 1 - n : n; const size_t mrow0 = (size_t)(gch0 + cn) * 64;
#pragma unroll
        for (int pt = 0; pt < 2; ++pt)
#pragma unroll
            for (int i = 0; i < 16; ++i) {
                const int pi = pt * 32 + crow(i, hh), tl = dir ? 63 - pi : pi;
                Oout[(mrow0 + tl) * 512 + h * 128 + slab * 32 + r32] = f2bf(o[pt][i]);
            }
    };
    __syncthreads();
    if (loader) {
        LRegs RA, RB;
        issue(0, RA); issue(1, RB); commit(0, RA); issue(2, RA);
        __syncthreads();
        for (int n = 0; n < N; n += 2) {
            commit(1, RB); if (n + 3 < N) issue(n + 3, RB);
            __syncthreads();
            if (n + 2 < N) { commit(0, RA); if (n + 4 < N) issue(n + 4, RA); }
            __syncthreads();
        }
    } else {
        URegs UA, UB;
        uload(0, UA); uload(1, UB);
        __syncthreads();
        for (int n = 0; n < N; n += 2) {
            compute(n, 0, UA);
            __syncthreads();
            compute(n + 1, 1, UB);
            __syncthreads();
        }
    }
}

constexpr int LDA_ = 1024, LDO_ = 1024;
constexpr size_t SHM_V = 64 * 128 * 2, SHM_K = 64 * 128 * 2;
#define KSWZ(row, colB) ((row) * 256 + ((colB) ^ (((row) & 7) << 4)))
#define SBAR() __builtin_amdgcn_sched_barrier(0)

DI unsigned cvtpk_a(float lo, float hi) { unsigned r; asm volatile("v_cvt_pk_bf16_f32 %0, %1, %2" : "=v"(r) : "v"(lo), "v"(hi)); return r; }
DI float smA_max0(const f32x16& p0) {
    float mx = p0[0];
#pragma unroll
    for (int r = 1; r < 16; ++r) mx = fmaxf(mx, p0[r]);
    return mx;
}
DI float smA_max1(float mx, const f32x16& p1) {
#pragma unroll
    for (int r = 0; r < 16; ++r) mx = fmaxf(mx, p1[r]);
    auto rr = __builtin_amdgcn_permlane32_swap(__float_as_uint(mx), __float_as_uint(mx), false, false);
    return fmaxf(__uint_as_float(rr[0]), __uint_as_float(rr[1]));
}
template <int LO> DI void smA_exp(f32x16& p0) {
#pragma unroll
    for (int r = LO; r < LO + 8; ++r) p0[r] = __builtin_amdgcn_exp2f(p0[r]);
}
template <bool FIRST> DI void smB(f32x16& p0, f32x16& p1, float pmax, float& m_reg, float& alpha) {
    if (!FIRST && __builtin_expect(__all(pmax <= ATHR2), 1)) { alpha = 1.f; }
    else {
        const float delta = FIRST ? pmax : fmaxf(pmax, 0.f);
        alpha = __builtin_amdgcn_exp2f(-delta); m_reg += delta;
#pragma unroll
        for (int r = 0; r < 16; ++r) { p0[r] *= alpha; p1[r] -= delta; }
    }
}
template <bool FIRST> DI void partialSM(f32x16& p0, f32x16& p1, float& m_reg, float& alpha) {
    const float pmax = smA_max1(smA_max0(p0), p1);
    smA_exp<0>(p0); smA_exp<8>(p0);
    smB<FIRST>(p0, p1, pmax, m_reg, alpha);
}
DI void finishSM(f32x16& p0, f32x16& p1, float alpha, float& l_reg, bf16x8& pa0, bf16x8& pa1, bf16x8& pa2, bf16x8& pa3) {
#pragma unroll
    for (int r = 0; r < 16; ++r) p1[r] = __builtin_amdgcn_exp2f(p1[r]);
    float ps = 0;
#pragma unroll
    for (int r = 0; r < 16; ++r) ps += p0[r];
#pragma unroll
    for (int r = 0; r < 16; ++r) ps += p1[r];
    { auto rr = __builtin_amdgcn_permlane32_swap(__float_as_uint(ps), __float_as_uint(ps), false, false);
      ps = __uint_as_float(rr[0]) + __uint_as_float(rr[1]); }
    l_reg = l_reg * alpha + ps;
#define PK4(P, BASE, OUT) do { unsigned a0 = cvtpk_a(P[BASE + 0], P[BASE + 1]), a1 = cvtpk_a(P[BASE + 2], P[BASE + 3]);   \
    unsigned b0 = cvtpk_a(P[BASE + 4], P[BASE + 5]), b1 = cvtpk_a(P[BASE + 6], P[BASE + 7]);                              \
    auto r0 = __builtin_amdgcn_permlane32_swap(a0, b0, false, false); auto r1 = __builtin_amdgcn_permlane32_swap(a1, b1, false, false); \
    u32x4 w = {r0[0], r1[0], r0[1], r1[1]}; OUT = __builtin_bit_cast(bf16x8, w); } while (0)
    PK4(p0, 0, pa0); PK4(p0, 8, pa1); PK4(p1, 0, pa2); PK4(p1, 8, pa3);
#undef PK4
}
DI void qkt(f32x16& p0, f32x16& p1, const char* Ks, const bf16x8* qr, float negm, int r32, int hi) {
#pragma unroll
    for (int i = 0; i < 16; ++i) { p0[i] = negm; p1[i] = negm; }
#pragma unroll
    for (int d0 = 0; d0 < 8; ++d0) { const int cb = (d0 * 16 + hi * 8) * 2;
        bf16x8 b0 = *(const bf16x8*)(Ks + KSWZ(r32, cb));
        bf16x8 b1 = *(const bf16x8*)(Ks + KSWZ(32 + r32, cb));
        p0 = MFMA32(b0, qr[d0], p0);
        p1 = MFMA32(b1, qr[d0], p1); }
}
DI int v_st(int k, int c) { const int kk = (k & ~0xC) | ((k & 4) << 1) | ((k & 8) >> 1); return ((kk >> 3) * 4 + (c >> 5)) * 512 + ((kk & 7) * 32 + (c & 31)) * 2; }
DI int v_rd_base(int lane) { return ((lane & 3) << 3) | (((lane >> 2) & 3) << 6) | (((lane >> 4) & 1) << 5) | (((lane >> 5) & 1) << 8); }
constexpr int v_rd_off(int d0, int ks, int half) { return d0 * 512 + ks * 4096 + half * 2048; }
template <int OFF> DI s16x4 tr_read(int vb) { s16x4 r; asm volatile("ds_read_b64_tr_b16 %0, %1 offset:%2" : "=&v"(r) : "v"(vb), "i"(OFF) : "memory"); return r; }
template <int D0> DI void pv_one(f32x16& od, int vb, bf16x8 pa0, bf16x8 pa1, bf16x8 pa2, bf16x8 pa3) {
    const s16x4 l0 = tr_read<v_rd_off(D0, 0, 0)>(vb), h0 = tr_read<v_rd_off(D0, 0, 1)>(vb), l1 = tr_read<v_rd_off(D0, 1, 0)>(vb), h1 = tr_read<v_rd_off(D0, 1, 1)>(vb);
    const s16x4 l2 = tr_read<v_rd_off(D0, 2, 0)>(vb), h2 = tr_read<v_rd_off(D0, 2, 1)>(vb), l3 = tr_read<v_rd_off(D0, 3, 0)>(vb), h3 = tr_read<v_rd_off(D0, 3, 1)>(vb);
    asm volatile("s_waitcnt lgkmcnt(0)" ::: "memory"); SBAR();
#define PK(L, H) (bf16x8){L[0], L[1], L[2], L[3], H[0], H[1], H[2], H[3]}
    od = MFMA32(pa0, PK(l0, h0), od);
    od = MFMA32(pa1, PK(l1, h1), od);
    od = MFMA32(pa2, PK(l2, h2), od);
    od = MFMA32(pa3, PK(l3, h3), od);
#undef PK
}
DI float pv_d0_sm(f32x16* o, int vb, bf16x8 pa0, bf16x8 pa1, bf16x8 pa2, bf16x8 pa3, f32x16& q0, f32x16& q1) {
    pv_one<0>(o[0], vb, pa0, pa1, pa2, pa3); const float mx0 = smA_max0(q0);
    pv_one<1>(o[1], vb, pa0, pa1, pa2, pa3); const float pmax = smA_max1(mx0, q1);
    pv_one<2>(o[2], vb, pa0, pa1, pa2, pa3); smA_exp<0>(q0);
    pv_one<3>(o[3], vb, pa0, pa1, pa2, pa3); smA_exp<8>(q0);
    return pmax;
}
DI void pv_d0(f32x16* o, int vb, bf16x8 pa0, bf16x8 pa1, bf16x8 pa2, bf16x8 pa3) {
    pv_one<0>(o[0], vb, pa0, pa1, pa2, pa3); pv_one<1>(o[1], vb, pa0, pa1, pa2, pa3); pv_one<2>(o[2], vb, pa0, pa1, pa2, pa3); pv_one<3>(o[3], vb, pa0, pa1, pa2, pa3);
}

DI void attn_unit(const bf16_t* __restrict__ Qb, const bf16_t* __restrict__ Kh, const bf16_t* __restrict__ Vh, bf16_t* __restrict__ Ob, const float* __restrict__ onw, int seq, char* lds) {
    int tid_ = threadIdx.x; asm volatile("" : "+v"(tid_));
    const int tid = tid_, wid = tid >> 6, lane = tid & 63, r32 = lane & 31, hi = lane >> 5;
    char* V_lds = lds; char* K_lds = lds + 2 * SHM_V;
    float* wsf = (float*)(lds + 2 * SHM_V + 2 * SHM_K) + wid * 64; float* li_l = wsf; float* al_l = wsf + 32;
    float m_reg = 0.f, l_reg = 0; f32x16 o[4]; bf16x8 qr[8];
#pragma unroll
    for (int d = 0; d < 4; ++d)
#pragma unroll
        for (int i = 0; i < 16; ++i) o[d][i] = 0.f;
    const bf16_t* Qw = Qb + (long)((wid & 3) * 32 + r32) * LDA_ + (wid >> 2) * 128 + hi * 8;
#pragma unroll
    for (int d0 = 0; d0 < 8; ++d0) qr[d0] = *(const bf16x8*)(Qw + d0 * 16);
    const int sr = tid >> 4, sc = (tid & 15) * 8, vst0 = v_st(sr, sc), vst1 = v_st(32 + sr, sc);
    const int vb0 = (int)(uintptr_t)V_lds + v_rd_base(lane);
    struct { bf16x8 vs0, vs1, ks0, ks1; } sr_[1];
#define SLOAD(i, k0) do { sr_[i].vs0 = *(const bf16x8*)(&Vh[(long)((k0) + sr) * LDA_ + sc]); sr_[i].vs1 = *(const bf16x8*)(&Vh[(long)((k0) + 32 + sr) * LDA_ + sc]); \
    sr_[i].ks0 = *(const bf16x8*)(&Kh[(long)((k0) + sr) * LDA_ + sc]); sr_[i].ks1 = *(const bf16x8*)(&Kh[(long)((k0) + 32 + sr) * LDA_ + sc]); } while (0)
#define SWRITE(b, i) do { *(bf16x8*)(V_lds + (b) * SHM_V + vst0) = sr_[i].vs0;          \
    *(bf16x8*)(V_lds + (b) * SHM_V + vst1) = sr_[i].vs1; int kc = sc * 2;               \
    *(bf16x8*)(K_lds + (b) * SHM_K + KSWZ(sr, kc)) = sr_[i].ks0;                       \
    *(bf16x8*)(K_lds + (b) * SHM_K + KSWZ(32 + sr, kc)) = sr_[i].ks1; } while (0)
#define SWAIT() asm volatile("s_waitcnt vmcnt(0)" ::: "memory")
#define RESC(a) do { if (__any((a) < 1.f)) { if (hi == 0) al_l[r32] = (a); asm volatile("s_waitcnt lgkmcnt(0)" ::: "memory"); \
    _Pragma("unroll") for (int d = 0; d < 4; ++d) _Pragma("unroll") for (int r = 0; r < 16; ++r) o[d][r] *= al_l[crow(r, hi)]; } } while (0)
    f32x16 pA0, pA1, pB0, pB1; float alA, alB; bf16x8 pa0, pa1, pa2, pa3; const int NT = seq / 64;
    constexpr int SE = 0, SO = 0;
    SLOAD(SE, 0); asm volatile("s_waitcnt vmcnt(0)" ::: "memory"); SWRITE(0, SE); __syncthreads();
    qkt(pA0, pA1, K_lds, qr, 0.f, r32, hi); partialSM<true>(pA0, pA1, m_reg, alA);
    SLOAD(SO, 64);
    SWAIT(); SWRITE(1, SO); __syncthreads();
    for (int j = 1; j + 1 < NT; j += 2) {
        SBAR(); qkt(pB0, pB1, K_lds + SHM_K, qr, -m_reg, r32, hi);
        finishSM(pA0, pA1, alA, l_reg, pa0, pa1, pa2, pa3); SBAR();
        SLOAD(SO, (j + 1) * 64); SBAR();
        { const float pm = pv_d0_sm(o, vb0, pa0, pa1, pa2, pa3, pB0, pB1); smB<false>(pB0, pB1, pm, m_reg, alB); }
        __syncthreads(); SWAIT(); SWRITE(0, SE);
        RESC(alB); __syncthreads();
        SBAR(); qkt(pA0, pA1, K_lds, qr, -m_reg, r32, hi);
        finishSM(pB0, pB1, alB, l_reg, pa0, pa1, pa2, pa3); SBAR();
        SLOAD(SE, (j + 2) * 64); SBAR();
        { const float pm = pv_d0_sm(o, vb0 + (int)SHM_V, pa0, pa1, pa2, pa3, pA0, pA1); smB<false>(pA0, pA1, pm, m_reg, alA); }
        __syncthreads(); SWAIT(); SWRITE(1, SO);
        RESC(alA); __syncthreads();
    }
    SBAR(); qkt(pB0, pB1, K_lds + SHM_K, qr, -m_reg, r32, hi);
    finishSM(pA0, pA1, alA, l_reg, pa0, pa1, pa2, pa3); SBAR();
    { const float pm = pv_d0_sm(o, vb0, pa0, pa1, pa2, pa3, pB0, pB1); smB<false>(pB0, pB1, pm, m_reg, alB); }
    __syncthreads(); RESC(alB);
    finishSM(pB0, pB1, alB, l_reg, pa0, pa1, pa2, pa3); SBAR();
    pv_d0(o, vb0 + (int)SHM_V, pa0, pa1, pa2, pa3);
    if (hi == 0) li_l[r32] = l_reg; asm volatile("s_waitcnt lgkmcnt(0)" ::: "memory");
    float wn[4];
#pragma unroll
    for (int d0 = 0; d0 < 4; ++d0) wn[d0] = onw[d0 * 32 + r32];
    bf16_t* Ow = Ob + (long)((wid & 3) * 32) * LDO_ + (wid >> 2) * 128;
#pragma unroll
    for (int r = 0; r < 16; ++r) {
        const int orow = crow(r, hi);
        const float rl = __builtin_amdgcn_rcpf(li_l[orow]);
        float v[4]; float ss = 0.f;
#pragma unroll
        for (int d0 = 0; d0 < 4; ++d0) { v[d0] = o[d0][r] * rl; ss += v[d0] * v[d0]; }
#pragma unroll
        for (int of = 16; of >= 1; of >>= 1) ss += __shfl_xor(ss, of);
        const float rs = rsqrtf(ss * (1.f / 128.f) + 1e-6f);
#pragma unroll
        for (int d0 = 0; d0 < 4; ++d0) Ow[(long)orow * LDO_ + d0 * 32 + r32] = f2bf(v[d0] * rs * wn[d0]);
    }
#undef SLOAD
#undef SWRITE
#undef SWAIT
#undef RESC
}

DI void phase_dn_combine(const Params& p) {
    char* ws = p.ws;
    const bf16_t* of = (const bf16_t*)(ws + OFF_OF); const bf16_t* ob = (const bf16_t*)(ws + OFF_OB); const bf16_t* z = (const bf16_t*)(ws + OFF_Z);
    bf16_t* mix = (bf16_t*)(ws + OFF_MIX);
    const int j = threadIdx.x & 15;
    const int gid = (blockIdx.x * NTHR + threadIdx.x) >> 4, ng = (gridDim.x * NTHR) >> 4;
    float nw[8];
#pragma unroll
    for (int e = 0; e < 8; ++e) nw[e] = p.dn_norm_w[j * 8 + e];
    for (int u0 = gid; u0 < M_TOK * 4; u0 += 2 * ng) {
        u32x4 a[2], b[2], zz[2]; bool ok[2];
#pragma unroll
        for (int q = 0; q < 2; ++q) {
            const int u = u0 + q * ng; ok[q] = u < M_TOK * 4;
            if (ok[q]) { const size_t off = (size_t)u * 128 + j * 8; a[q] = *(const u32x4*)(of + off); b[q] = *(const u32x4*)(ob + off); zz[q] = *(const u32x4*)(z + off); }
            else { a[q] = (u32x4){0u, 0u, 0u, 0u}; b[q] = a[q]; zz[q] = a[q]; }
        }
#pragma unroll
        for (int q = 0; q < 2; ++q) {
            const int u = u0 + q * ng;
            const unsigned aa[4] = {a[q].x, a[q].y, a[q].z, a[q].w}, bb[4] = {b[q].x, b[q].y, b[q].z, b[q].w}, zq[4] = {zz[q].x, zz[q].y, zz[q].z, zz[q].w};
            float v[8], zf[8]; float ss = 0.f;
#pragma unroll
            for (int e = 0; e < 4; ++e) { v[2 * e] = bflo(aa[e]) + bflo(bb[e]); v[2 * e + 1] = bfhi(aa[e]) + bfhi(bb[e]); zf[2 * e] = bflo(zq[e]); zf[2 * e + 1] = bfhi(zq[e]); }
#pragma unroll
            for (int e = 0; e < 8; ++e) ss += v[e] * v[e];
#pragma unroll
            for (int o = 8; o >= 1; o >>= 1) ss += __shfl_xor(ss, o);
            const float rs = rsqrtf(ss * (1.f / 128.f) + 1e-6f);
            float r[8];
#pragma unroll
            for (int e = 0; e < 8; ++e) r[e] = v[e] * rs * nw[e] * silu_f(zf[e]);
            if (ok[q]) *(u32x4*)(mix + (size_t)(u >> 2) * 1024 + 512 + (u & 3) * 128 + j * 8) = (u32x4){cvtpk(r[0], r[1]), cvtpk(r[2], r[3]), cvtpk(r[4], r[5]), cvtpk(r[6], r[7])};
        }
    }
}

DI void phase_ffn_act(const Params& p, int slab) {
    char* ws = p.ws;
    const bf16_t* us = (const bf16_t*)(ws + OFF_US); bf16_t* act = (bf16_t*)(ws + OFF_ACT);
    constexpr int NG = DFFP / 8;
    const int nthreads = gridDim.x * NTHR, tpg = nthreads / NG;
    const int gt = blockIdx.x * NTHR + threadIdx.x, cg8 = gt % NG, sidx = gt / NG;
    if (sidx >= tpg) return;
    const int seglen = (MSLAB + tpg - 1) / tpg;
    const int t_beg = sidx * seglen, t_end = min(MSLAB, t_beg + seglen);
    const int c8 = cg8 * 8, m0 = slab * MSLAB;
    if (c8 >= DFF) { for (int ml = t_beg; ml < t_end; ++ml) *(u32x4*)(act + (size_t)ml * DFFP + c8) = (u32x4){0u, 0u, 0u, 0u}; return; }
    float wg[3][8], wu[3][8], bg[8], bu[8];
#pragma unroll
    for (int e = 0; e < 8; ++e) { bg[e] = p.ffn_conv_b[c8 + e]; bu[e] = p.ffn_conv_b[DFF + c8 + e]; }
#pragma unroll
    for (int j = 0; j < 3; ++j)
#pragma unroll
        for (int e = 0; e < 8; ++e) { wg[j][e] = p.ffn_conv_w[(size_t)j * DFF2 + c8 + e]; wu[j][e] = p.ffn_conv_w[(size_t)j * DFF2 + DFF + c8 + e]; }
    auto ldrow = [&](int ml, u32x4& g, u32x4& u) {
        if (ml >= 0 && ml < MSLAB) { const bf16_t* row = us + (size_t)ml * DFF2; g = *(const u32x4*)(row + c8); u = *(const u32x4*)(row + DFF + c8); }
        else { g = (u32x4){0u, 0u, 0u, 0u}; u = g; }
    };
    u32x4 gp, up, gc, uc, gn, un, gn2, un2, gn3, un3, gn4, un4;
    ldrow(t_beg - 1, gp, up); ldrow(t_beg, gc, uc); ldrow(t_beg + 1, gn, un); ldrow(t_beg + 2, gn2, un2); ldrow(t_beg + 3, gn3, un3);
    for (int ml = t_beg; ml < t_end; ++ml) {
        ldrow(ml + 4, gn4, un4);
        int base, t, T; seq_of(m0 + ml, base, t, T);
        const float mp = t > 0 ? 1.f : 0.f, mn = t + 1 < T ? 1.f : 0.f;
        const unsigned gpa[4] = {gp.x, gp.y, gp.z, gp.w}, gca[4] = {gc.x, gc.y, gc.z, gc.w}, gna[4] = {gn.x, gn.y, gn.z, gn.w};
        const unsigned upa[4] = {up.x, up.y, up.z, up.w}, uca[4] = {uc.x, uc.y, uc.z, uc.w}, una[4] = {un.x, un.y, un.z, un.w};
        float r[8];
#pragma unroll
        for (int e = 0; e < 4; ++e) {
            const float g0 = bg[2 * e] + mp * bflo(gpa[e]) * wg[0][2 * e] + bflo(gca[e]) * wg[1][2 * e] + mn * bflo(gna[e]) * wg[2][2 * e];
            const float g1 = bg[2 * e + 1] + mp * bfhi(gpa[e]) * wg[0][2 * e + 1] + bfhi(gca[e]) * wg[1][2 * e + 1] + mn * bfhi(gna[e]) * wg[2][2 * e + 1];
            const float u0 = bu[2 * e] + mp * bflo(upa[e]) * wu[0][2 * e] + bflo(uca[e]) * wu[1][2 * e] + mn * bflo(una[e]) * wu[2][2 * e];
            const float u1 = bu[2 * e + 1] + mp * bfhi(upa[e]) * wu[0][2 * e + 1] + bfhi(uca[e]) * wu[1][2 * e + 1] + mn * bfhi(una[e]) * wu[2][2 * e + 1];
            r[2 * e] = silu_f(g0) * u0; r[2 * e + 1] = silu_f(g1) * u1;
        }
        *(u32x4*)(act + (size_t)ml * DFFP + c8) = (u32x4){cvtpk(r[0], r[1]), cvtpk(r[2], r[3]), cvtpk(r[4], r[5]), cvtpk(r[6], r[7])};
        gp = gc; up = uc; gc = gn; uc = un; gn = gn2; un = un2; gn2 = gn3; un2 = un3; gn3 = gn4; un3 = un4;
    }
}

constexpr int NPHASE = 14;
constexpr int Q_DNS = 16, Q_ATS = 512, Q_DNP = 256, Q_ATP = 1024, Q_TOTAL = Q_DNS + Q_ATS + Q_DNP + Q_ATP;

DI void run_phase(const Params& p, int ph, char* lds) {
    char* ws = p.ws;
    switch (ph) {
    case 0: phase0(p, lds); break;
    case 1: {
        FInProj f{(bf16_t*)((char*)p.out + 2 * U1), (bf16_t*)(ws + OFF_PROJD), (bf16_t*)(ws + OFF_Z), (float*)(ws + OFF_GATES)};
        run_gemm(lds, (const bf16_t*)p.out, (const bf16_t*)(ws + OFF_WIN), 1024, M_TOK / 256, INWP / 256, f);
    } break;
    case 2: {
        phase_attn_prep(p);
        {
            u32x2 xr[20];
#pragma unroll
            for (int r = 0; r < 20; ++r) xr[r] = (u32x2){0u, 0u};
            if ((int)blockIdx.x < NCHUNK * 4) dn_prep_load(p, blockIdx.x >> 2, blockIdx.x & 3, xr);
            for (int u = blockIdx.x; u < NCHUNK * 4; u += gridDim.x) {
                const int un = u + gridDim.x;
                dn_prep_unit(p, u >> 2, u & 3, lds, xr, un < NCHUNK * 4 ? (un >> 2) : -1, un & 3);
            }
        }
    } break;
    case 3: {
        unsigned* ctr = (unsigned*)(ws + OFF_CTR);
        int* item_s = (int*)(lds + LDS_BYTES - 16);
        const bf16_t* bufA = (const bf16_t*)((char*)p.out + 2 * U1);
        bf16_t* ao = (bf16_t*)(ws + OFF_MIX);
        for (;;) {
            __syncthreads();
            if (threadIdx.x == 0) *item_s = (int)atomicAdd(ctr, 1u);
            __syncthreads();
            const int it = __builtin_amdgcn_readfirstlane(*item_s);
            if (it >= Q_TOTAL) break;
#ifndef SKIP_SCAN
            if (it < Q_DNS) { const int sq = it >> 3; dn_scan_item(p, MP + sq * 16384, 16384, (it >> 1) & 3, it & 1, lds); }
#else
            if (it < Q_DNS) {}
#endif
            else if (it >= Q_DNS + Q_ATS && it < Q_DNS + Q_ATS + Q_DNP) {
#ifndef SKIP_SCAN
                const int u = it - Q_DNS - Q_ATS; dn_scan_item(p, (u >> 3) * 2048, 2048, (u >> 1) & 3, u & 1, lds);
#endif
            } else {
                size_t r0; int kvh, qb, seq;
                if (it < Q_DNS + Q_ATS) { const int u = it - Q_DNS, bk = u >> 7; qb = u & 127; kvh = bk & 1; r0 = (size_t)MP + (size_t)(bk >> 1) * 16384; seq = 16384; }
                else { const int u = it - Q_DNS - Q_ATS - Q_DNP, bk = u >> 4; qb = u & 15; kvh = bk & 1; r0 = (size_t)(bk >> 1) * 2048; seq = 2048; }
#ifndef SKIP_ATTN
                attn_unit(bufA + (r0 + qb * 128) * 1024 + kvh * 256, bufA + r0 * 1024 + 512 + kvh * 128, bufA + r0 * 1024 + 768 + kvh * 128,
                          ao + (r0 + qb * 128) * 1024 + kvh * 256, p.o_norm_w, seq, lds);
#endif
            }
        }
    } break;
    case 4: phase_dn_combine(p); break;
    case 5: {
        pg8::Gemm g{(const bf16_t*)(ws + OFF_MIX), (const bf16_t*)(ws + OFF_WOUT), M_TOK, 1024, 1024};
        pg8::XcdOrder S; S.init(M_TOK / 256, 4);
        EpiOutProj E{p.x_prompt, p.x_sample, p.out, (bf16_t*)(ws + OFF_H2), (float*)(ws + OFF_SS)};
        pg8::gemm_phase<EpiOutProj, pg8::XcdOrder, true, true>((PG8_LAS unsigned char*)lds, g, S, E);
    } break;
    case 6: break;
    case 7: case 10: {
        const int slab = ph == 7 ? 0 : 1;
        FU f{(bf16_t*)(ws + OFF_US), (const float*)(ws + OFF_SS) + (size_t)slab * MSLAB};
        run_gemm(lds, (const bf16_t*)(ws + OFF_H2) + (size_t)slab * MSLAB * 1024, (const bf16_t*)(ws + OFF_WFFI), 1024, MSLAB / 256, DFF2P / 256, f);
    } break;
    case 8: case 11: phase_ffn_act(p, ph == 8 ? 0 : 1); break;
    case 9: case 12: {
        const int slab = ph == 9 ? 0 : 1;
        FResOut f{p.out + (size_t)slab * MSLAB * DM};
        run_gemm(lds, (const bf16_t*)(ws + OFF_ACT), (const bf16_t*)(ws + OFF_WFFO), DFFP, MSLAB / 256, 4, f);
    } break;
    default: break;
    }
}

DI void grid_bar(unsigned* ctr, unsigned target) {
    asm volatile("s_waitcnt vmcnt(0)" ::: "memory");
    __syncthreads();
    if (threadIdx.x == 0) {
        __builtin_amdgcn_fence(__ATOMIC_RELEASE, "agent");
        asm volatile("s_waitcnt vmcnt(0)" ::: "memory");
        __hip_atomic_fetch_add(ctr, 1u, __ATOMIC_RELAXED, __HIP_MEMORY_SCOPE_AGENT);
        while (__hip_atomic_load(ctr, __ATOMIC_RELAXED, __HIP_MEMORY_SCOPE_AGENT) < target) __builtin_amdgcn_s_sleep(4);
        __builtin_amdgcn_fence(__ATOMIC_ACQUIRE, "agent");
        asm volatile("s_waitcnt vmcnt(0)" ::: "memory");
    }
    __syncthreads();
}

__global__ void __launch_bounds__(NTHR) mega(Params p, int ph0, int ph1) {
    extern __shared__ __attribute__((aligned(16))) char lds[];
    cg::grid_group grid = cg::this_grid();
#ifdef ONLY_PH
    run_phase(p, ONLY_PH, lds);
#else
    unsigned* bar = (unsigned*)(p.ws + OFF_CTR + 1024);
    run_phase(p, 0, lds); grid.sync();
    run_phase(p, 1, lds); grid_bar(bar, 1u * gridDim.x);
    run_phase(p, 2, lds); grid_bar(bar, 2u * gridDim.x);
    run_phase(p, 3, lds); grid_bar(bar, 3u * gridDim.x);
    run_phase(p, 4, lds); grid_bar(bar, 4u * gridDim.x);
    run_phase(p, 5, lds); grid_bar(bar, 5u * gridDim.x);
    run_phase(p, 7, lds); grid_bar(bar, 6u * gridDim.x);
    run_phase(p, 8, lds); grid_bar(bar, 7u * gridDim.x);
    run_phase(p, 9, lds);
    run_phase(p, 10, lds); grid_bar(bar, 8u * gridDim.x);
    run_phase(p, 11, lds); grid_bar(bar, 9u * gridDim.x);
    run_phase(p, 12, lds);
#endif
}

extern "C" void kernel_launch(void* const* d_in, const int* in_sizes, int n_in, void* d_out, int out_size, void* d_ws, size_t ws_size, hipStream_t stream) {
    static int grid_blocks = 0;
    if (!grid_blocks) {
        hipFuncSetAttribute((const void*)mega, hipFuncAttributeMaxDynamicSharedMemorySize, LDS_BYTES);
        int dev = 0, cus = 0, per_cu = 0;
        hipGetDevice(&dev);
        hipDeviceGetAttribute(&cus, hipDeviceAttributeMultiprocessorCount, dev);
        hipOccupancyMaxActiveBlocksPerMultiprocessor(&per_cu, mega, NTHR, LDS_BYTES);
        if (per_cu < 1) per_cu = 1;
        grid_blocks = cus;
        if (grid_blocks % 8) grid_blocks -= grid_blocks % 8;
    }
    Params p{};
    p.x_prompt = (const float*)d_in[0]; p.x_sample = (const float*)d_in[1]; p.norm1_w = (const float*)d_in[2]; p.w_in = (const float*)d_in[3];
    p.dn_conv_w = (const float*)d_in[4]; p.A_log_f = (const float*)d_in[5]; p.A_log_b = (const float*)d_in[6]; p.dt_f = (const float*)d_in[7];
    p.dt_b = (const float*)d_in[8]; p.dn_norm_w = (const float*)d_in[9]; p.q_norm_w = (const float*)d_in[10]; p.k_norm_w = (const float*)d_in[11];
    p.o_norm_w = (const float*)d_in[12]; p.w_out = (const float*)d_in[13]; p.norm2_w = (const float*)d_in[14]; p.w_ffn_in = (const float*)d_in[15];
    p.ffn_conv_w = (const float*)d_in[16]; p.ffn_conv_b = (const float*)d_in[17]; p.w_ffn_out = (const float*)d_in[18];
    p.out = (float*)d_out; p.ws = (char*)d_ws;
    hipMemsetAsync((char*)d_ws + OFF_CTR, 0, 4096, stream);
    int ph0 = 0, ph1 = NPHASE - 1;
    void* args[] = {&p, &ph0, &ph1};
    hipError_t e = hipLaunchCooperativeKernel((void*)mega, dim3(grid_blocks), dim3(NTHR), args, LDS_BYTES, stream);
    if (e != hipSuccess) fprintf(stderr, "cooperative launch failed: %s (grid %d)\n", hipGetErrorString(e), grid_blocks);
}
```

```cpp
#include <hip/hip_runtime.h>
#include <hip/hip_cooperative_groups.h>
#include <cstdio>
#include <cstdint>
#include <utility>
namespace cg = cooperative_groups;

typedef unsigned short bf16_t;
typedef short bf16x8 __attribute__((ext_vector_type(8)));
typedef short s16x4 __attribute__((ext_vector_type(4)));
typedef float f32x16 __attribute__((ext_vector_type(16)));
typedef float f32x4 __attribute__((ext_vector_type(4)));
typedef float f32x2 __attribute__((ext_vector_type(2)));
typedef unsigned u32x4 __attribute__((ext_vector_type(4)));
typedef unsigned u32x2 __attribute__((ext_vector_type(2)));
typedef __bf16 bfv2 __attribute__((ext_vector_type(2)));
#define DI __device__ __forceinline__
#define MFMA32(a, b, c) __builtin_amdgcn_mfma_f32_32x32x16_bf16((a), (b), (c), 0, 0, 0)

constexpr int M_TOK = 98304, MP = 65536, DM = 1024;
constexpr int INW = 3088, INWP = 3328, DFF = 2752, DFF2 = 5504, DFF2P = 5632;
constexpr int NTHR = 512;
constexpr size_t U1 = (size_t)M_TOK * 512 * 2;
constexpr int LDS_BYTES = 163840;
constexpr int NCHUNK = M_TOK / 64;
constexpr int MSLAB = M_TOK / 2;
constexpr int DFFP = 2816;
constexpr size_t OFF_WIN = 0;
constexpr size_t OFF_WOUT = OFF_WIN + (size_t)INWP * 1024 * 2;
constexpr size_t OFF_WFFI = OFF_WOUT + (size_t)1024 * 1024 * 2;
constexpr size_t OFF_WFFO = OFF_WFFI + (size_t)DFF2P * 1024 * 2;
constexpr size_t OFF_ROPE = OFF_WFFO + (size_t)1024 * DFFP * 2;
constexpr size_t OFF_CTR = OFF_ROPE + 65536;
constexpr size_t OFF_GATES = OFF_CTR + 65536;
constexpr size_t OFF_Z = OFF_GATES + (size_t)M_TOK * 16 * 4;
constexpr size_t OFF_WC = OFF_Z + U1;
constexpr size_t OFF_UC = OFF_WC + 2 * U1;
constexpr size_t OFF_AC = OFF_UC + 2 * U1;
constexpr size_t OFF_GC = OFF_AC + U1;
constexpr size_t OFF_PROJD = OFF_GC + (size_t)NCHUNK * 8 * 64 * 4;
constexpr size_t OFF_MIX = OFF_PROJD, OFF_OF = OFF_PROJD + 2 * U1, OFF_OB = OFF_PROJD + 3 * U1;
constexpr size_t OFF_H2 = OFF_GATES;
constexpr size_t OFF_US = OFF_H2 + 2 * U1;
constexpr size_t OFF_ACT = OFF_US + (size_t)MSLAB * DFF2 * 2;
constexpr size_t OFF_SS = OFF_ACT + (size_t)MSLAB * DFFP * 2;
static_assert(OFF_SS >= OFF_PROJD + 4 * U1 && OFF_SS + (size_t)M_TOK * 4 <= 1073741824ull, "ws map");
static_assert(OFF_PROJD + 4 * U1 <= 1073741824ull, "ws map");
static_assert(OFF_ACT + (size_t)MSLAB * DFFP * 2 <= 1073741824ull, "ws map");
static_assert(OFF_WIN % 256 == 0 && OFF_GATES % 256 == 0 && OFF_PROJD % 256 == 0 && OFF_US % 256 == 0 && OFF_ACT % 256 == 0, "ws align");

struct Params {
    const float* x_prompt; const float* x_sample; const float* norm1_w; const float* w_in; const float* dn_conv_w;
    const float* A_log_f; const float* A_log_b; const float* dt_f; const float* dt_b; const float* dn_norm_w;
    const float* q_norm_w; const float* k_norm_w; const float* o_norm_w; const float* w_out; const float* norm2_w;
    const float* w_ffn_in; const float* ffn_conv_w; const float* ffn_conv_b; const float* w_ffn_out;
    float* out; char* ws;
};

DI float bf2f(bf16_t v) { return __uint_as_float(((unsigned)v) << 16); }
DI unsigned cvtpk(float lo, float hi) { f32x2 v = {lo, hi}; bfv2 r = __builtin_convertvector(v, bfv2); return __builtin_bit_cast(unsigned, r); }
DI bf16_t f2bf(float x) { return (bf16_t)(cvtpk(x, 0.f) & 0xffffu); }
DI float bflo(unsigned w) { return __uint_as_float(w << 16); }
DI float bfhi(unsigned w) { return __uint_as_float(w & 0xffff0000u); }
DI int crow(int r, int hi) { return (r & 3) + 8 * (r >> 2) + 4 * hi; }
DI float silu_f(float v) { return v * __builtin_amdgcn_rcpf(1.f + __expf(-v)); }
DI const float* xrow(const Params& p, int m) { return m < MP ? p.x_prompt + (size_t)m * DM : p.x_sample + (size_t)(m - MP) * DM; }
DI void seq_of(int m, int& base, int& t, int& T) { if (m < MP) { base = m & ~2047; t = m & 2047; T = 2048; } else { int r = m - MP; base = MP + (r & ~16383); t = r & 16383; T = 16384; } }
DI bf16x8 pack8(const f32x16& x, int s) {
    u32x4 w = {cvtpk(x[8 * s], x[8 * s + 1]), cvtpk(x[8 * s + 2], x[8 * s + 3]), cvtpk(x[8 * s + 4], x[8 * s + 5]), cvtpk(x[8 * s + 6], x[8 * s + 7])};
    return __builtin_bit_cast(bf16x8, w);
}
DI bf16x8 ld2x64(const char* p0, const char* p1) { u32x2 a = *(const u32x2*)p0, b = *(const u32x2*)p1; u32x4 w = {a.x, a.y, b.x, b.y}; return __builtin_bit_cast(bf16x8, w); }

DI void transpose_w(const float* in, int K, int N, bf16_t* out, int Kpad, int tile, char* lds, const float* kscale = nullptr) {
    float* tl = (float*)lds;
    const int nkt = Kpad / 64, tid = threadIdx.x;
    const int k0 = (tile % nkt) * 64, n0 = (tile / nkt) * 64;
    __syncthreads();
#pragma unroll
    for (int i = 0; i < 8; ++i) { int nl = tid & 63, kl = (tid >> 6) + 8 * i; int n = n0 + nl; float v = (n < N && k0 + kl < K) ? in[(size_t)(k0 + kl) * N + n] : 0.f; if (kscale) v *= kscale[k0 + kl]; tl[kl * 65 + nl] = v; }
    __syncthreads();
#pragma unroll
    for (int i = 0; i < 8; ++i) { int kl = tid & 63, nl = (tid >> 6) + 8 * i; out[(size_t)(n0 + nl) * Kpad + k0 + kl] = f2bf(tl[kl * 65 + nl]); }
}

DI void rmsnorm_rows(const Params& p, bool from_out, const float* w, bf16_t* dst) {
    const int wid = threadIdx.x >> 6, lane = threadIdx.x & 63;
    const int gw = blockIdx.x * 8 + wid, nw = gridDim.x * 8;
    f32x4 wv[4];
#pragma unroll
    for (int i = 0; i < 4; ++i) wv[i] = *(const f32x4*)(w + i * 256 + lane * 4);
    for (int m0 = gw; m0 < M_TOK; m0 += 2 * nw) {
        f32x4 v[2][4];
#pragma unroll
        for (int q = 0; q < 2; ++q) {
            const int m = min(m0 + q * nw, M_TOK - 1);
            const float* src = from_out ? (const float*)(p.out + (size_t)m * DM) : xrow(p, m);
#pragma unroll
            for (int i = 0; i < 4; ++i) v[q][i] = *(const f32x4*)(src + i * 256 + lane * 4);
        }
#pragma unroll
        for (int q = 0; q < 2; ++q) {
            const int m = m0 + q * nw;
            float ss = 0.f;
#pragma unroll
            for (int i = 0; i < 4; ++i) ss += v[q][i][0] * v[q][i][0] + v[q][i][1] * v[q][i][1] + v[q][i][2] * v[q][i][2] + v[q][i][3] * v[q][i][3];
#pragma unroll
            for (int o = 32; o >= 1; o >>= 1) ss += __shfl_xor(ss, o);
            const float rs = rsqrtf(ss * (1.f / 1024.f) + 1e-6f);
            if (m < M_TOK) {
#pragma unroll
                for (int i = 0; i < 4; ++i) {
                    u32x2 o2 = {cvtpk(v[q][i][0] * rs * wv[i][0], v[q][i][1] * rs * wv[i][1]), cvtpk(v[q][i][2] * rs * wv[i][2], v[q][i][3] * rs * wv[i][3])};
                    *(u32x2*)(dst + (size_t)m * DM + i * 256 + lane * 4) = o2;
                }
            }
        }
    }
}

__device__ const double kInvFreq[32] = {1.0, 0.7498942093324559, 0.5623413251903491, 0.4216965034285822, 0.31622776601683794, 0.23713737056616552, 0.1778279410038923, 0.1333521432163324, 0.1, 0.07498942093324558, 0.05623413251903491, 0.042169650342858224, 0.03162277660168379, 0.023713737056616554, 0.01778279410038923, 0.01333521432163324, 0.01, 0.007498942093324558, 0.005623413251903491, 0.004216965034285823, 0.0031622776601683794, 0.0023713737056616554, 0.0017782794100389228, 0.001333521432163324, 0.001, 0.0007498942093324559, 0.0005623413251903491, 0.00042169650342858224, 0.00031622776601683794, 0.00023713737056616554, 0.00017782794100389227, 0.0001333521432163324};

DI void phase0(const Params& p, char* lds) {
    char* ws = p.ws;
    const int nt0 = 16 * (INWP / 64), nt1 = 16 * 16, nt2 = 16 * (DFF2P / 64), nt3 = (DFFP / 64) * 16;
    for (int t = blockIdx.x; t < nt0 + nt1 + nt2 + nt3; t += gridDim.x) {
        if (t < nt0) transpose_w(p.w_in, 1024, INW, (bf16_t*)(ws + OFF_WIN), 1024, t, lds);
        else if (t < nt0 + nt1) transpose_w(p.w_out, 1024, 1024, (bf16_t*)(ws + OFF_WOUT), 1024, t - nt0, lds);
        else if (t < nt0 + nt1 + nt2) transpose_w(p.w_ffn_in, 1024, DFF2, (bf16_t*)(ws + OFF_WFFI), 1024, t - nt0 - nt1, lds, p.norm2_w);
        else transpose_w(p.w_ffn_out, DFF, 1024, (bf16_t*)(ws + OFF_WFFO), DFFP, t - nt0 - nt1 - nt2, lds);
    }
    if (blockIdx.x == 0 && threadIdx.x < 32) {
        const double w = kInvFreq[threadIdx.x], w2 = w * w;
        double sn = 0.0, cs = 0.0, ts = w, tc = 1.0;
        for (int k = 0; k < 12; ++k) { sn += ts; cs += tc; tc = -tc * w2 / ((2 * k + 1) * (2 * k + 2)); ts = -ts * w2 / ((2 * k + 2) * (2 * k + 3)); }
        double c = 1.0, s = 0.0; float* tab = (float*)(ws + OFF_ROPE);
        for (int pos = 0; pos < 256; ++pos) { tab[(pos * 32 + threadIdx.x) * 2] = (float)c; tab[(pos * 32 + threadIdx.x) * 2 + 1] = (float)s; double c2 = c * cs - s * sn, s2 = s * cs + c * sn; c = c2; s = s2; }
    }
    if (blockIdx.x == 0 && threadIdx.x == 64) { atomicExch((unsigned*)(ws + OFF_CTR), 0u); }
    if (blockIdx.x == 0 && threadIdx.x >= 128 && threadIdx.x < 128 + 34) atomicExch((unsigned*)(ws + OFF_CTR + 2048) + (threadIdx.x - 128), 0u);
    for (int i = blockIdx.x * NTHR + threadIdx.x; i < M_TOK; i += gridDim.x * NTHR) ((float*)(ws + OFF_SS))[i] = 0.f;
    rmsnorm_rows(p, false, p.norm1_w, (bf16_t*)p.out);
}

namespace pg8 {
#define PG8_LAS __attribute__((address_space(3)))
constexpr int BM = 256, BK = 64, HALF = 128, HTB = HALF * BK * 2, STAGE_BYTES = 8 * HTB;
DI int lds_byte(int r, int c) { const int st = (r >> 4) * 2 + (c >> 5), rr = r & 15, cc = c & 31, ob = rr * 64 + cc * 2; return st * 1024 + (ob ^ (((ob >> 9) & 1) << 5)); }
DI void stage_rc(int b, int& R, int& C) { const int st = b / 1024, sb = b % 1024, swz = sb ^ (((sb >> 9) & 1) << 5); R = (st >> 1) * 16 + swz / 64; C = (st & 1) * 32 + (swz % 64) / 2; }
DI int perm32(int rho) { const int n = rho >> 4, i = rho & 15; return 8 * (i >> 2) + 4 * n + (i & 3); }
struct Unit { int pm, pn; };
struct Gemm { const bf16_t* A; const bf16_t* Bt; int M, N, K; };
struct XcdOrder {
    int nN, mpx, bpx, xcd, loc, total;
    DI void init(int mt_cnt, int nN_) { nN = nN_; mpx = mt_cnt / 8; bpx = gridDim.x / 8; xcd = blockIdx.x % 8; loc = blockIdx.x / 8; total = mpx * nN; }
    DI bool next(int i, Unit& u) const {
        const int j = loc + i * bpx; if (j >= total) return false;
        const int grp = j / (4 * nN), rem = j % (4 * nN);
        u.pm = xcd * mpx + grp * 4 + (rem & 3); u.pn = rem >> 2; return true;
    }
    DI void a_ready(const Unit&) const {}
    DI void done(const Unit&) const {}
};
template <class Epi, class Sched, bool ALIGN_EPI = false, bool SP2 = false>
__device__ __forceinline__ void gemm_phase(PG8_LAS unsigned char* lds, const Gemm g, const Sched& S, const Epi& E) {
    const int tid = threadIdx.x, wid = __builtin_amdgcn_readfirstlane(tid >> 6), lane = tid & 63, wr = wid >> 2, wc = wid & 3, fr = lane & 15, fq = lane >> 4;
    const int K = g.K, nt = K / BK;
    unsigned voffA[2], voffB[2];
#pragma unroll
    for (int i = 0; i < 2; ++i) { int R, C; stage_rc(tid * 16 + i * 8192, R, C); const int Rb = Epi::PERM ? ((R & ~31) + perm32(R & 31)) : R;
        voffA[i] = (unsigned)(R * K + C) * 2u; voffB[i] = (unsigned)(Rb * K + C) * 2u; }
    const size_t kstep = (size_t)(BK * 2);
    const size_t hstep = (size_t)HALF * K * 2;
    const size_t tstep = 2 * hstep;
    const unsigned ldsw = (unsigned)wid * 1024u;
    const int aoff = lds_byte(wr * 64 + fr, fq * 8), boff = lds_byte(wc * 32 + fr, fq * 8);
#define PG8_SA(b, h) (((b) * 2 + (h)) * HTB)
#define PG8_SB(b, h) ((4 + (b) * 2 + (h)) * HTB)
#define PG8_STAGE(bufoff, gbase, voff) do { _Pragma("unroll") for (int _i = 0; _i < 2; ++_i) \
        __builtin_amdgcn_global_load_lds((const unsigned*)((const char*)(gbase) + (voff)[_i]), (PG8_LAS unsigned*)(lds + (bufoff) + ldsw + _i * 8192), 16, 0, 0); } while (0)
#define PG8_LDA(dst, b, h) do { _Pragma("unroll") for (int m = 0; m < 4; ++m) _Pragma("unroll") for (int k = 0; k < 2; ++k) dst[m][k] = *(const PG8_LAS bf16x8*)(lds + PG8_SA(b, h) + aoff + m * 2048 + k * 1024); } while (0)
#define PG8_LDB(dst, b, h) do { _Pragma("unroll") for (int n = 0; n < 2; ++n) _Pragma("unroll") for (int k = 0; k < 2; ++k) dst[n][k] = *(const PG8_LAS bf16x8*)(lds + PG8_SB(b, h) + boff + n * 2048 + k * 1024); } while (0)
#define PG8_MMA(ai, bj, At, Bt) do { __builtin_amdgcn_s_setprio(1); _Pragma("unroll") for (int m = 0; m < 4; ++m) _Pragma("unroll") for (int n = 0; n < 2; ++n) _Pragma("unroll") for (int k = 0; k < 2; ++k) \
        acc[ai][bj][m][n] = __builtin_amdgcn_mfma_f32_16x16x32_bf16(Bt[n][k], At[m][k], acc[ai][bj][m][n], 0, 0, 0); __builtin_amdgcn_s_setprio(0); } while (0)
#define PG8_WAIT_V(n) asm volatile("s_waitcnt vmcnt(" #n ")" ::: "memory")
#define PG8_WAIT_L(n) asm volatile("s_waitcnt lgkmcnt(" #n ")" ::: "memory")
#define PG8_BAR __builtin_amdgcn_s_barrier()
#define PG8_SCHED __builtin_amdgcn_sched_barrier(0)
    Unit cur, nxt; int ui = 0;
    if (!S.next(0, cur)) return;
    f32x4 acc[2][2][4][2];
#pragma unroll
    for (int a = 0; a < 2; ++a)
#pragma unroll
        for (int b = 0; b < 2; ++b)
#pragma unroll
            for (int m = 0; m < 4; ++m)
#pragma unroll
                for (int n = 0; n < 2; ++n) acc[a][b][m][n] = (f32x4){0.f, 0.f, 0.f, 0.f};
    bf16x8 At[4][2], B0[2][2], B1[2][2];
    const char* cA = (const char*)g.A + (size_t)cur.pm * tstep; const char* cB = (const char*)g.Bt + (size_t)cur.pn * tstep;
    S.a_ready(cur);
    if constexpr (SP2) {
        PG8_STAGE(PG8_SB(0, 0), cB, voffB); PG8_STAGE(PG8_SB(0, 1), cB + hstep, voffB); PG8_STAGE(PG8_SA(0, 0), cA, voffA); PG8_STAGE(PG8_SA(0, 1), cA + hstep, voffA);
        if (wr == 1) PG8_BAR;
        PG8_WAIT_V(2); PG8_BAR;
        PG8_STAGE(PG8_SB(1, 0), cB + kstep, voffB); PG8_STAGE(PG8_SA(1, 0), cA + kstep, voffA); PG8_STAGE(PG8_SB(1, 1), cB + hstep + kstep, voffB);
        PG8_WAIT_V(6); PG8_BAR;
    } else {
        PG8_STAGE(PG8_SB(0, 0), cB, voffB); PG8_STAGE(PG8_SA(0, 0), cA, voffA); PG8_STAGE(PG8_SB(0, 1), cB + hstep, voffB); PG8_STAGE(PG8_SA(0, 1), cA + hstep, voffA);
        if (wr == 1) PG8_BAR;
        PG8_WAIT_V(4); PG8_BAR;
        PG8_STAGE(PG8_SB(1, 0), cB + kstep, voffB); PG8_STAGE(PG8_SA(1, 0), cA + kstep, voffA); PG8_STAGE(PG8_SB(1, 1), cB + hstep + kstep, voffB);
        PG8_WAIT_V(6); PG8_BAR;
    }
    for (;;) {
        const bool has_next = S.next(ui + 1, nxt);
        const char* nA = has_next ? (const char*)g.A + (size_t)nxt.pm * tstep : cA; const char* nB = has_next ? (const char*)g.Bt + (size_t)nxt.pn * tstep : cB;
        for (int t = 0; t < nt; t += 2) {
            const bool last = (t == nt - 2);
            const char* a1 = cA + (size_t)(t + 1) * kstep;
            const char* a2 = last ? nA : cA + (size_t)(t + 2) * kstep; const char* b2 = last ? nB : cB + (size_t)(t + 2) * kstep;
            const char* a3 = a2 + kstep; const char* b3 = b2 + kstep;
            if (last && has_next) S.a_ready(nxt);
            if constexpr (SP2) {
            PG8_LDB(B0, 0, 0); PG8_LDB(B1, 0, 1); PG8_SCHED; PG8_LDA(At, 0, 0); PG8_STAGE(PG8_SA(1, 1), a1 + hstep, voffA);
            PG8_WAIT_V(8); PG8_WAIT_L(0); PG8_BAR; PG8_MMA(0, 0, At, B0); PG8_MMA(0, 1, At, B1); PG8_BAR; PG8_SCHED;
            PG8_LDA(At, 0, 1); PG8_STAGE(PG8_SB(0, 0), b2, voffB); PG8_STAGE(PG8_SB(0, 1), b2 + hstep, voffB); PG8_STAGE(PG8_SA(0, 0), a2, voffA);
            PG8_WAIT_V(8); PG8_WAIT_L(0); PG8_BAR; PG8_MMA(1, 0, At, B0); PG8_MMA(1, 1, At, B1); PG8_BAR; PG8_SCHED;
            PG8_LDB(B0, 1, 0); PG8_LDB(B1, 1, 1); PG8_SCHED; PG8_LDA(At, 1, 0); PG8_STAGE(PG8_SA(0, 1), a2 + hstep, voffA);
            PG8_WAIT_V(8); PG8_WAIT_L(0); PG8_BAR; PG8_MMA(0, 0, At, B0); PG8_MMA(0, 1, At, B1); PG8_BAR; PG8_SCHED;
            PG8_LDA(At, 1, 1); PG8_STAGE(PG8_SB(1, 0), b3, voffB); PG8_STAGE(PG8_SB(1, 1), b3 + hstep, voffB); PG8_STAGE(PG8_SA(1, 0), a3, voffA);
            PG8_WAIT_V(8); PG8_WAIT_L(0); PG8_BAR; PG8_MMA(1, 0, At, B0); PG8_MMA(1, 1, At, B1); PG8_BAR; PG8_SCHED;
            } else {
            PG8_LDB(B0, 0, 0); PG8_SCHED; PG8_LDA(At, 0, 0); PG8_STAGE(PG8_SA(1, 1), a1 + hstep, voffA);
            PG8_WAIT_L(8); PG8_BAR; PG8_WAIT_L(0); PG8_MMA(0, 0, At, B0); PG8_BAR; PG8_SCHED;
            PG8_LDB(B1, 0, 1); PG8_STAGE(PG8_SB(0, 0), b2, voffB);
            PG8_BAR; PG8_WAIT_L(0); PG8_MMA(0, 1, At, B1); PG8_BAR;
            PG8_LDA(At, 0, 1); PG8_STAGE(PG8_SA(0, 0), a2, voffA);
            PG8_BAR; PG8_WAIT_L(0); PG8_MMA(1, 0, At, B0); PG8_BAR; PG8_SCHED;
            PG8_STAGE(PG8_SB(0, 1), b2 + hstep, voffB);
            PG8_WAIT_V(6); PG8_BAR; PG8_MMA(1, 1, At, B1); PG8_BAR;
            PG8_LDB(B0, 1, 0); PG8_SCHED; PG8_LDA(At, 1, 0); PG8_STAGE(PG8_SA(0, 1), a2 + hstep, voffA);
            PG8_WAIT_L(8); PG8_BAR; PG8_WAIT_L(0); PG8_MMA(0, 0, At, B0); PG8_BAR; PG8_SCHED;
            PG8_LDB(B1, 1, 1); PG8_STAGE(PG8_SB(1, 0), b3, voffB);
            PG8_BAR; PG8_WAIT_L(0); PG8_MMA(0, 1, At, B1); PG8_BAR;
            PG8_LDA(At, 1, 1); PG8_STAGE(PG8_SA(1, 0), a3, voffA);
            PG8_BAR; PG8_WAIT_L(0); PG8_MMA(1, 0, At, B0); PG8_BAR; PG8_SCHED;
            PG8_STAGE(PG8_SB(1, 1), b3 + hstep, voffB);
            PG8_WAIT_V(6); PG8_BAR; PG8_MMA(1, 1, At, B1); PG8_BAR;
            }
        }
        if constexpr (ALIGN_EPI) { if (wr == 0) PG8_BAR; }
        if constexpr (!Epi::AFTER_DRAIN) { E(acc, cur, wr, wc, fr, fq); S.done(cur); }
        if (!has_next) break;
#pragma unroll
        for (int a = 0; a < 2; ++a)
#pragma unroll
            for (int b = 0; b < 2; ++b)
#pragma unroll
                for (int m = 0; m < 4; ++m)
#pragma unroll
                    for (int n = 0; n < 2; ++n) acc[a][b][m][n] = (f32x4){0.f, 0.f, 0.f, 0.f};
        cur = nxt; cA = nA; cB = nB; ++ui;
        if constexpr (ALIGN_EPI) { if (wr == 1) PG8_BAR; }
    }
    PG8_WAIT_V(0);
    if constexpr (!ALIGN_EPI) { if (wr == 0) PG8_BAR; }
    PG8_BAR;
    if constexpr (Epi::AFTER_DRAIN) { E.fused(acc, cur, wr, wc, fr, fq, lds, wid, lane); S.done(cur); }
#undef PG8_SA
#undef PG8_SB
#undef PG8_STAGE
#undef PG8_LDA
#undef PG8_LDB
#undef PG8_MMA
#undef PG8_WAIT_V
#undef PG8_WAIT_L
#undef PG8_BAR
#undef PG8_SCHED
}

template <class F> struct EpiRows {
    static constexpr bool PERM = true, AFTER_DRAIN = false;
    F f;
    DI void operator()(const f32x4 (&acc)[2][2][4][2], const Unit& u, int wr, int wc, int fr, int fq) const {
#pragma unroll
        for (int ai = 0; ai < 2; ++ai)
#pragma unroll
            for (int m = 0; m < 4; ++m) {
                const int r = u.pm * BM + ai * HALF + wr * 64 + m * 16 + fr;
#pragma unroll
                for (int bj = 0; bj < 2; ++bj) f(r, u.pn * BM + bj * HALF + wc * 32 + 8 * fq, acc[ai][bj][m][0], acc[ai][bj][m][1]);
                asm volatile("" ::: "memory");
            }
    }
};
}

DI void st_bf8(bf16_t* p, f32x4 a, f32x4 b) { u32x4 o = {cvtpk(a[0], a[1]), cvtpk(a[2], a[3]), cvtpk(b[0], b[1]), cvtpk(b[2], b[3])}; *(u32x4*)p = o; }

struct FInProj { bf16_t* bufA; bf16_t* projD; bf16_t* bufZ; float* gates;
    DI void operator()(int m, int n0, f32x4 a, f32x4 b) const {
        if (n0 < 1024) st_bf8(bufA + (size_t)m * 1024 + n0, a, b);
        else if (n0 < 2560) st_bf8(projD + (size_t)m * 1536 + (n0 - 1024), a, b);
        else if (n0 < 3072) st_bf8(bufZ + (size_t)m * 512 + (n0 - 2560), a, b);
        else if (n0 < 3088) { float* g = gates + (size_t)m * 16 + (n0 - 3072); *(f32x4*)g = a; *(f32x4*)(g + 4) = b; }
    } };
struct FResX { const float* xp; const float* xs; float* out;
    DI void operator()(int m, int n0, f32x4 a, f32x4 b) const {
        const float* xr = (m < MP ? xp + (size_t)m * DM : xs + (size_t)(m - MP) * DM) + n0;
        const f32x4 r0 = *(const f32x4*)xr, r1 = *(const f32x4*)(xr + 4);
        float* o = out + (size_t)m * DM + n0; *(f32x4*)o = r0 + a; *(f32x4*)(o + 4) = r1 + b;
    } };
struct FU { bf16_t* us; const float* ss;
    DI void operator()(int m, int n0, f32x4 a, f32x4 b) const { if (n0 < DFF2) { const float rs = rsqrtf(ss[m] * (1.f / 1024.f) + 1e-6f); st_bf8(us + (size_t)m * DFF2 + n0, a * rs, b * rs); } } };
struct FResOut { float* out;
    DI void operator()(int m, int n0, f32x4 a, f32x4 b) const { float* o = out + (size_t)m * DM + n0; const f32x4 r0 = *(const f32x4*)o, r1 = *(const f32x4*)(o + 4); *(f32x4*)o = r0 + a; *(f32x4*)(o + 4) = r1 + b; } };

struct EpiOutProj {
    static constexpr bool PERM = true, AFTER_DRAIN = false;
    const float* xp; const float* xs; float* out; bf16_t* xb; float* ss;
    DI void operator()(const f32x4 (&acc)[2][2][4][2], const pg8::Unit& u, int wr, int wc, int fr, int fq) const {
#pragma unroll
        for (int ai = 0; ai < 2; ++ai)
#pragma unroll
            for (int m = 0; m < 4; ++m) {
                const int r = u.pm * 256 + ai * 128 + wr * 64 + m * 16 + fr;
                const float* xr = (r < MP ? xp + (size_t)r * DM : xs + (size_t)(r - MP) * DM);
                float part = 0.f;
#pragma unroll
                for (int bj = 0; bj < 2; ++bj) {
                    const int n0 = u.pn * 256 + bj * 128 + wc * 32 + 8 * fq;
                    const f32x4 v0 = *(const f32x4*)(xr + n0) + acc[ai][bj][m][0], v1 = *(const f32x4*)(xr + n0 + 4) + acc[ai][bj][m][1];
                    float* o = out + (size_t)r * DM + n0; *(f32x4*)o = v0; *(f32x4*)(o + 4) = v1;
                    st_bf8(xb + (size_t)r * DM + n0, v0, v1);
                    part += (v0[0] * v0[0] + v0[1] * v0[1]) + (v0[2] * v0[2] + v0[3] * v0[3]) + (v1[0] * v1[0] + v1[1] * v1[1]) + (v1[2] * v1[2] + v1[3] * v1[3]);
                }
                part += __shfl_xor(part, 16); part += __shfl_xor(part, 32);
                if (fq == 0) atomicAdd(ss + r, part);
                asm volatile("" ::: "memory");
            }
    }
};

template <class F> DI void run_gemm(char* lds, const bf16_t* A, const bf16_t* Bt, int K, int mt_cnt, int nN, const F& f) {
    pg8::Gemm g{A, Bt, mt_cnt * 256, nN * 256, K};
    pg8::XcdOrder S; S.init(mt_cnt, nN);
    pg8::EpiRows<F> E{f};
    pg8::gemm_phase<pg8::EpiRows<F>, pg8::XcdOrder, true, true>((PG8_LAS unsigned char*)lds, g, S, E);
}

constexpr float ASCALE = 0.088388347648318440f;
constexpr float ATHR2 = 8.f * 1.4426950408889634f;
DI void phase_attn_prep(const Params& p) {
    bf16_t* bufA = (bf16_t*)((char*)p.out + 2 * U1);
    const float* tab = (const float*)(p.ws + OFF_ROPE);
    const int j = threadIdx.x & 7;
    const int gid = (blockIdx.x * NTHR + threadIdx.x) >> 3, ng = (gridDim.x * NTHR) >> 3;
    float wq[16], wk[16];
#pragma unroll
    for (int qd_ = 0; qd_ < 4; ++qd_)
#pragma unroll
        for (int e = 0; e < 4; ++e) { wq[qd_ * 4 + e] = p.q_norm_w[qd_ * 32 + 4 * j + e]; wk[qd_ * 4 + e] = p.k_norm_w[qd_ * 32 + 4 * j + e]; }
    for (int u0 = gid; u0 < M_TOK * 6; u0 += 2 * ng) {
        u32x2 raw[2][4]; bool ok[2];
#pragma unroll
        for (int q = 0; q < 2; ++q) {
            const int u = u0 + q * ng; ok[q] = u < M_TOK * 6;
            const int uu = ok[q] ? u : 0; const int m = uu / 6, slot = uu - m * 6;
            const bf16_t* ptr = bufA + (size_t)m * 1024 + slot * 128 + 4 * j;
#pragma unroll
            for (int qd_ = 0; qd_ < 4; ++qd_) raw[q][qd_] = *(const u32x2*)(ptr + 32 * qd_);
        }
#pragma unroll
        for (int q = 0; q < 2; ++q) {
            const int u = u0 + q * ng; const int uu = ok[q] ? u : 0; const int m = uu / 6, slot = uu - m * 6;
            int base, t, T; seq_of(m, base, t, T);
            float v[16]; float ss = 0.f;
#pragma unroll
            for (int qd_ = 0; qd_ < 4; ++qd_) { v[qd_ * 4] = bflo(raw[q][qd_].x); v[qd_ * 4 + 1] = bfhi(raw[q][qd_].x); v[qd_ * 4 + 2] = bflo(raw[q][qd_].y); v[qd_ * 4 + 3] = bfhi(raw[q][qd_].y); }
#pragma unroll
            for (int e = 0; e < 16; ++e) ss += v[e] * v[e];
#pragma unroll
            for (int o = 4; o >= 1; o >>= 1) ss += __shfl_xor(ss, o);
            const float rs = rsqrtf(ss * (1.f / 128.f) + 1e-6f);
            const float rsq = slot < 4 ? rs * (ASCALE * 1.4426950408889634f) : rs;
#pragma unroll
            for (int e = 0; e < 16; ++e) v[e] = v[e] * rsq * (slot < 4 ? wq[e] : wk[e]);
            const int pr = t >> 6, pc = t & 63;
            const f32x4* tr = (const f32x4*)(tab + (pr * 32 + 4 * j) * 2); const f32x4* tc = (const f32x4*)(tab + (pc * 32 + 4 * j) * 2);
            const f32x4 r0 = tr[0], r1 = tr[1], c0 = tc[0], c1 = tc[1];
            const float cr[4] = {r0[0], r0[2], r1[0], r1[2]}, sr[4] = {r0[1], r0[3], r1[1], r1[3]};
            const float cc[4] = {c0[0], c0[2], c1[0], c1[2]}, sc[4] = {c0[1], c0[3], c1[1], c1[3]};
            float o[16];
#pragma unroll
            for (int e = 0; e < 4; ++e) {
                o[e] = v[e] * cr[e] - v[4 + e] * sr[e]; o[4 + e] = v[4 + e] * cr[e] + v[e] * sr[e];
                o[8 + e] = v[8 + e] * cc[e] - v[12 + e] * sc[e]; o[12 + e] = v[12 + e] * cc[e] + v[8 + e] * sc[e];
            }
            if (ok[q]) {
                bf16_t* ptr = bufA + (size_t)m * 1024 + slot * 128 + 4 * j;
#pragma unroll
                for (int qd_ = 0; qd_ < 4; ++qd_) *(u32x2*)(ptr + 32 * qd_) = (u32x2){cvtpk(o[qd_ * 4], o[qd_ * 4 + 1]), cvtpk(o[qd_ * 4 + 2], o[qd_ * 4 + 3])};
            }
        }
    }
}

constexpr int PL_QB = 0, PL_KB = 16896, PL_VT = 33792, PL_KT = 52224, PL_GKK = 70656, PL_LF = 70656, PL_GQK = 87040, PL_LB = 103424, PL_T = 119808, PL_SM = 156672;

template <int PI> DI void tsolve_row(float (&x)[64], const float* L, int j, f32x4 (&lc)[8], f32x4 (&ln)[8]) {
    f32x4 lh[8];
#pragma unroll
    for (int s4 = 8; s4 < (PI + 3) / 4; ++s4) lh[s4 - 8] = *(const f32x4*)(L + PI * 64 + 4 * s4);
    if (PI + 1 < 64) {
#pragma unroll
        for (int s4 = 0; s4 < (PI + 4) / 4 && s4 < 8; ++s4) ln[s4] = *(const f32x4*)(L + (PI + 1) * 64 + 4 * s4);
    }
    asm volatile("" ::: "memory");
    float a[4] = {(PI == j) ? 1.f : 0.f, 0.f, 0.f, 0.f};
#pragma unroll
    for (int s4 = 0; s4 < (PI + 3) / 4 && s4 < 8; ++s4) {
#pragma unroll
        for (int k = 0; k < 4; ++k) if (4 * s4 + k < PI) a[k] -= lc[s4][k] * x[4 * s4 + k];
    }
#pragma unroll
    for (int s4 = 8; s4 < (PI + 3) / 4; ++s4) {
#pragma unroll
        for (int k = 0; k < 4; ++k) if (4 * s4 + k < PI) a[k] -= lh[s4 - 8][k] * x[4 * s4 + k];
    }
    x[PI] = (a[0] + a[1]) + (a[2] + a[3]);
}
template <int PI> DI void tsolve_pair(float (&x)[64], const float* L, int j, f32x4 (&la)[8], f32x4 (&lb)[8]) {
    tsolve_row<2 * PI>(x, L, j, la, lb);
    tsolve_row<2 * PI + 1>(x, L, j, lb, la);
}
template <int... Is> DI void tsolve_all(float (&x)[64], const float* L, int j, std::integer_sequence<int, Is...>) {
    f32x4 la[8], lb[8];
    (tsolve_pair<Is>(x, L, j, la, lb), ...);
}
template <int... Is> DI void tstore_all(const float (&x)[64], char* TU, char* TW, float mu, float mw, std::integer_sequence<int, Is...>) {
    ((*(bf16_t*)(TU + Is * 144) = f2bf(x[Is] * mu), *(bf16_t*)(TW + Is * 144) = f2bf(x[Is] * mw)), ...);
}

DI void dn_prep_load(const Params& p, int gchunk, int h, u32x2 (&xr)[20]) {
    int tid = threadIdx.x; asm volatile("" : "+v"(tid));
    if (tid < 384) {
        const bf16_t* projD = (const bf16_t*)(p.ws + OFF_PROJD);
        const int c4 = tid & 31, grp = tid >> 5, seg = grp >> 2, tq = grp & 3;
        const int ch = seg * 512 + h * 128 + c4 * 4;
        int base, t0, T; seq_of(gchunk * 64, base, t0, T);
#pragma unroll
        for (int r = 0; r < 20; ++r) {
            const int t = t0 + tq * 16 + r - 2;
            if (t >= 0 && t < T) xr[r] = *(const u32x2*)(projD + (size_t)(base + t) * 1536 + ch);
            else xr[r] = (u32x2){0u, 0u};
        }
    }
}

DI void dn_prep_unit(const Params& p, int gchunk, int h, char* lds, u32x2 (&xr)[20], int gchunk_n, int h_n) {
    int tid_ = threadIdx.x; asm volatile("" : "+v"(tid_));
    const int tid = tid_, wid = tid >> 6, lane = tid & 63, r32 = lane & 31, hh = lane >> 5;
    char* ws = p.ws;
    const float* gates = (const float*)(ws + OFF_GATES);
    bf16_t* qd = (bf16_t*)p.out; bf16_t* kd = (bf16_t*)((char*)p.out + U1);
    const int m0 = gchunk * 64;
    int base, t0, T; seq_of(m0, base, t0, T);
    float* Gkk = (float*)(lds + PL_GKK); float* Gqk = (float*)(lds + PL_GQK);
    float* sm = (float*)(lds + PL_SM);
    __syncthreads();
#ifndef SKIP_CONV
    if (tid < 384) {
        const int c4 = tid & 31, grp = tid >> 5, seg = grp >> 2, tq = grp & 3;
        const int ch = seg * 512 + h * 128 + c4 * 4;
        f32x4 w[5];
#pragma unroll
        for (int j = 0; j < 5; ++j) w[j] = *(const f32x4*)(p.dn_conv_w + j * 1536 + ch);
        f32x4 x[20];
#pragma unroll
        for (int r = 0; r < 20; ++r) x[r] = (f32x4){bflo(xr[r].x), bfhi(xr[r].x), bflo(xr[r].y), bfhi(xr[r].y)};
        unsigned tp[4][8];
#pragma unroll
        for (int i = 0; i < 16; i += 2) {
            f32x4 yy[2];
#pragma unroll
            for (int ii = 0; ii < 2; ++ii) {
                f32x4 a = x[i + ii] * w[0];
#pragma unroll
                for (int j = 1; j < 5; ++j) a += x[i + ii + j] * w[j];
                f32x4 y = {silu_f(a[0]), silu_f(a[1]), silu_f(a[2]), silu_f(a[3])};
                const int tl = tq * 16 + i + ii;
                if (seg < 2) {
                    float ss = y[0] * y[0] + y[1] * y[1] + y[2] * y[2] + y[3] * y[3];
#pragma unroll
                    for (int o = 16; o >= 1; o >>= 1) ss += __shfl_xor(ss, o);
                    float sc = rsqrtf(ss + 1e-6f); if (seg == 0) sc *= 0.08838834764831845f;
                    y = y * sc;
                    u32x2 o2 = {cvtpk(y[0], y[1]), cvtpk(y[2], y[3])};
                    *(u32x2*)(lds + (seg == 0 ? PL_QB : PL_KB) + tl * 264 + c4 * 8) = o2;
                    *(u32x2*)((seg == 0 ? qd : kd) + (size_t)(m0 + tl) * 512 + h * 128 + c4 * 4) = o2;
                }
                yy[ii] = y;
            }
#pragma unroll
            for (int e = 0; e < 4; ++e) tp[e][i >> 1] = cvtpk(yy[0][e], yy[1][e]);
        }
        if (seg >= 1) {
            char* dstT = lds + (seg == 1 ? PL_KT : PL_VT);
#pragma unroll
            for (int e = 0; e < 4; ++e) {
                char* d = dstT + (c4 * 4 + e) * 144 + tq * 32;
                *(u32x4*)d = (u32x4){tp[e][0], tp[e][1], tp[e][2], tp[e][3]};
                *(u32x4*)(d + 16) = (u32x4){tp[e][4], tp[e][5], tp[e][6], tp[e][7]};
            }
        }
    } else
#endif
    if (tid >= 384 && tid < 512) {
        const int dir = wid - 6, pidx = lane, tl = dir ? 63 - pidx : pidx;
        const float a = gates[(size_t)(m0 + tl) * 16 + dir * 4 + h], b = gates[(size_t)(m0 + tl) * 16 + 8 + dir * 4 + h];
        const float Al = dir ? p.A_log_b[h] : p.A_log_f[h], db = dir ? p.dt_b[h] : p.dt_f[h];
        const float xx = a + db; const float sp = xx > 20.f ? xx : log1pf(expf(xx));
        float g = -expf(Al) * sp; const float beta = 1.f / (1.f + expf(-b));
#pragma unroll
        for (int o = 1; o < 64; o <<= 1) { float n = __shfl_up(g, o); if (lane >= o) g += n; }
        sm[dir * 64 + pidx] = beta; sm[128 + dir * 64 + pidx] = g; sm[256 + dir * 64 + pidx] = beta; sm[384 + dir * 64 + pidx] = beta * __expf(g);
        ((float*)(ws + OFF_GC))[((size_t)(gchunk * 4 + h) * 2 + dir) * 64 + pidx] = g;
    }
    __syncthreads();
    if (gchunk_n >= 0) dn_prep_load(p, gchunk_n, h_n, xr);
    {
        const int mat = wid >> 2, ti = (wid >> 1) & 1, tj = wid & 1;
        const char* X = lds + (mat ? PL_QB : PL_KB); const char* Kb = lds + PL_KB;
        f32x16 acc;
#pragma unroll
        for (int i = 0; i < 16; ++i) acc[i] = 0.f;
#pragma unroll
        for (int ks = 0; ks < 8; ++ks) {
            const int off = (ks * 16 + hh * 8) * 2;
            bf16x8 a = ld2x64(X + (ti * 32 + r32) * 264 + off, X + (ti * 32 + r32) * 264 + off + 8);
            bf16x8 b = ld2x64(Kb + (tj * 32 + r32) * 264 + off, Kb + (tj * 32 + r32) * 264 + off + 8);
            acc = MFMA32(a, b, acc);
        }
        float* G = mat ? Gqk : Gkk;
#pragma unroll
        for (int i = 0; i < 16; ++i) G[(ti * 32 + crow(i, hh)) * 64 + tj * 32 + r32] = acc[i];
    }
    __syncthreads();
    {
        const int dir = tid >> 8, q = tid & 255, si = q & 63, p0 = (q >> 6) * 16;
        const float* beta = sm + dir * 64; const float* gc = sm + 128 + dir * 64;
        float* L = (float*)(lds + (dir ? PL_LB : PL_LF));
        bf16_t* Ac = (bf16_t*)(ws + OFF_AC) + ((size_t)(gchunk * 4 + h) * 2 + dir) * 4096;
        const int sx = dir ? 63 - si : si; const float gs = gc[si];
        float gk[16], gq[16];
#pragma unroll
        for (int k = 0; k < 16; ++k) { const int pi = p0 + k, c = dir ? 63 - pi : pi; gk[k] = Gkk[c * 64 + sx]; gq[k] = Gqk[c * 64 + sx]; }
        __syncthreads();
#pragma unroll
        for (int k = 0; k < 16; ++k) {
            const int pi = p0 + k;
            const float dec = (si <= pi) ? __expf(gc[pi] - gs) : 0.f;
            L[pi * 64 + si] = (si < pi) ? beta[pi] * gk[k] * dec : 0.f;
            Ac[pi * 64 + si] = f2bf(gq[k] * dec);
        }
    }
    __syncthreads();
    if (tid < 128) {
        const int dir = tid >> 6, j = tid & 63;
        const float* L = (const float*)(lds + (dir ? PL_LB : PL_LF));
        float x[64];
        tsolve_all(x, L, j, std::make_integer_sequence<int, 32>{});
        const int kpos = dir ? 63 - j : j;
        char* TU = lds + PL_T + (dir * 2) * 9216 + kpos * 2; char* TW = TU + 9216;
        tstore_all(x, TU, TW, sm[256 + dir * 64 + j], sm[384 + dir * 64 + j], std::make_integer_sequence<int, 64>{});
    }
    __syncthreads();
    {
        const int dir = wid >> 2, which = (wid >> 1) & 1, half = wid & 1;
        const char* Ta = lds + PL_T + (dir * 2 + which) * 9216;
        const char* Bm = lds + (which ? PL_KT : PL_VT);
        const size_t ci = (size_t)(gchunk * 4 + h) * 2 + dir;
        f32x16 acc[2][2];
#pragma unroll
        for (int a = 0; a < 2; ++a)
#pragma unroll
            for (int b = 0; b < 2; ++b)
#pragma unroll
                for (int i = 0; i < 16; ++i) acc[a][b][i] = 0.f;
#pragma unroll
        for (int ks = 0; ks < 4; ++ks) {
            const int ko = (ks * 16 + hh * 8) * 2;
            bf16x8 af[2], bfr[2];
#pragma unroll
            for (int pt = 0; pt < 2; ++pt) af[pt] = *(const bf16x8*)(Ta + (pt * 32 + r32) * 144 + ko);
#pragma unroll
            for (int ct = 0; ct < 2; ++ct) bfr[ct] = *(const bf16x8*)(Bm + (half * 64 + ct * 32 + r32) * 144 + ko);
#pragma unroll
            for (int pt = 0; pt < 2; ++pt)
#pragma unroll
                for (int ct = 0; ct < 2; ++ct) acc[pt][ct] = MFMA32(af[pt], bfr[ct], acc[pt][ct]);
        }
        if (which == 0) {
            bf16_t* Uc = (bf16_t*)(ws + OFF_UC) + ci * 8192;
#pragma unroll
            for (int pt = 0; pt < 2; ++pt)
#pragma unroll
                for (int ct = 0; ct < 2; ++ct) {
                    const f32x16& a = acc[pt][ct];
                    u32x4* d = (u32x4*)(Uc + (((half * 2 + ct) * 2 + pt) * 64 + lane) * 16);
                    d[0] = (u32x4){cvtpk(a[0], a[1]), cvtpk(a[2], a[3]), cvtpk(a[4], a[5]), cvtpk(a[6], a[7])};
                    d[1] = (u32x4){cvtpk(a[8], a[9]), cvtpk(a[10], a[11]), cvtpk(a[12], a[13]), cvtpk(a[14], a[15])};
                }
        } else {
            bf16_t* Wc = (bf16_t*)(ws + OFF_WC) + ci * 8192;
#pragma unroll
            for (int pt = 0; pt < 2; ++pt)
#pragma unroll
                for (int ct = 0; ct < 2; ++ct)
#pragma unroll
                    for (int i = 0; i < 16; ++i) Wc[(pt * 32 + crow(i, hh)) * 128 + half * 64 + ct * 32 + r32] = f2bf(-acc[pt][ct][i]);
        }
    }
}

constexpr int SL_W = 0, SL_QG = 16896, SL_KDT = 33792, SL_AT = 51200, SL_BUF = 59904;

DI void dn_scan_item(const Params& p, int seqbase, int T, int h, int dir, char* lds) {
    int tid_ = threadIdx.x; asm volatile("" : "+v"(tid_));
    const int tid = tid_, wid = __builtin_amdgcn_readfirstlane(tid >> 6), lane0 = tid & 63;
    char* ws = p.ws;
    const int N = T >> 6, gch0 = seqbase >> 6;
    const bf16_t* qd = (const bf16_t*)p.out; const bf16_t* kd = (const bf16_t*)((char*)p.out + U1);
    const bf16_t* WcB = (const bf16_t*)(ws + OFF_WC); const bf16_t* UcB = (const bf16_t*)(ws + OFF_UC);
    const bf16_t* AcB = (const bf16_t*)(ws + OFF_AC); const float* GcB = (const float*)(ws + OFF_GC);
    bf16_t* Oout = (bf16_t*)(ws + (dir ? OFF_OB : OFF_OF));
    const bool loader = wid >= 4;
    const int lt0 = tid - 256;

    struct LRegs { u32x4 rw[4], rq[4], rk[4], rat[2]; float gq[4]; float glast; };
    auto issue = [&](int n, LRegs& R) {
        int lt = lt0; asm volatile("" : "+v"(lt));
        const int cn = dir ? N - 1 - n : n; const int gchunk = gch0 + cn;
        const size_t ci = (size_t)(gchunk * 4 + h) * 2 + dir;
        const bf16_t* Wc = WcB + ci * 8192; const bf16_t* Ac = AcB + ci * 4096; const float* gc = GcB + ci * 64;
        R.glast = gc[63];
#pragma unroll
        for (int i = 0; i < 4; ++i) {
            const int q = lt + 256 * i, row = q >> 4, c16 = q & 15;
            const int tl = dir ? 63 - row : row; const size_t m = (size_t)gchunk * 64 + tl;
            R.rw[i] = *(const u32x4*)(Wc + row * 128 + c16 * 8);
            R.rq[i] = *(const u32x4*)(qd + m * 512 + h * 128 + c16 * 8);
            R.rk[i] = *(const u32x4*)(kd + m * 512 + h * 128 + c16 * 8);
            R.gq[i] = gc[row];
        }
#pragma unroll
        for (int i = 0; i < 2; ++i) { const int q = lt + 256 * i, row = q >> 3, c16 = q & 7; R.rat[i] = *(const u32x4*)(Ac + row * 64 + c16 * 8); }
    };
    auto commit = [&](int par, const LRegs& R) {
        int lt = lt0; asm volatile("" : "+v"(lt));
        char* buf = lds + par * SL_BUF;
#pragma unroll
        for (int i = 0; i < 4; ++i) {
            const int q = lt + 256 * i, row = q >> 4, c16 = q & 15;
            char* wd = buf + SL_W + row * 264 + c16 * 16;
            *(u32x2*)wd = (u32x2){R.rw[i].x, R.rw[i].y}; *(u32x2*)(wd + 8) = (u32x2){R.rw[i].z, R.rw[i].w};
            const float eq = __expf(R.gq[i]), ek = __expf(R.glast - R.gq[i]);
            unsigned qq[4] = {R.rq[i].x, R.rq[i].y, R.rq[i].z, R.rq[i].w}, kk[4] = {R.rk[i].x, R.rk[i].y, R.rk[i].z, R.rk[i].w};
            unsigned qo[4];
#pragma unroll
            for (int e = 0; e < 4; ++e) qo[e] = cvtpk(bflo(qq[e]) * eq, bfhi(qq[e]) * eq);
            char* qdst = buf + SL_QG + row * 264 + c16 * 16;
            *(u32x2*)qdst = (u32x2){qo[0], qo[1]}; *(u32x2*)(qdst + 8) = (u32x2){qo[2], qo[3]};
#pragma unroll
            for (int e = 0; e < 4; ++e) {
                const unsigned pk = cvtpk(bflo(kk[e]) * ek, bfhi(kk[e]) * ek);
                *(bf16_t*)(buf + SL_KDT + (c16 * 8 + 2 * e) * 136 + row * 2) = (bf16_t)(pk & 0xffffu);
                *(bf16_t*)(buf + SL_KDT + (c16 * 8 + 2 * e + 1) * 136 + row * 2) = (bf16_t)(pk >> 16);
            }
        }
#pragma unroll
        for (int i = 0; i < 2; ++i) {
            const int q = lt + 256 * i, row = q >> 3, c16 = q & 7;
            char* ad = buf + SL_AT + row * 136 + c16 * 16;
            *(u32x2*)ad = (u32x2){R.rat[i].x, R.rat[i].y}; *(u32x2*)(ad + 8) = (u32x2){R.rat[i].z, R.rat[i].w};
        }
    };

    f32x16 S[4];
#pragma unroll
    for (int d = 0; d < 4; ++d)
#pragma unroll
        for (int i = 0; i < 16; ++i) S[d][i] = 0.f;
    const int slab = wid & 3;
    struct URegs { u32x4 un[2][2]; float gl; };
    auto uload = [&](int n, URegs& U) {
        int lane = lane0; asm volatile("" : "+v"(lane));
        const int cn = dir ? N - 1 - n : n; const size_t ci = (size_t)((gch0 + cn) * 4 + h) * 2 + dir;
        const bf16_t* Uc = UcB + ci * 8192;
#pragma unroll
        for (int pt = 0; pt < 2; ++pt) { const u32x4* sp = (const u32x4*)(Uc + ((slab * 2 + pt) * 64 + lane) * 16); U.un[pt][0] = sp[0]; U.un[pt][1] = sp[1]; }
        U.gl = GcB[ci * 64 + 63];
    };
    auto compute = [&](int n, int par, URegs& U) {
        int lane = lane0; asm volatile("" : "+v"(lane));
        const int r32 = lane & 31, hh = lane >> 5;
        const char* buf = lds + par * SL_BUF;
        f32x16 vn[2], o[2];
#pragma unroll
        for (int pt = 0; pt < 2; ++pt) {
            const unsigned uu[8] = {U.un[pt][0].x, U.un[pt][0].y, U.un[pt][0].z, U.un[pt][0].w, U.un[pt][1].x, U.un[pt][1].y, U.un[pt][1].z, U.un[pt][1].w};
#pragma unroll
            for (int e = 0; e < 8; ++e) { vn[pt][2 * e] = bflo(uu[e]); vn[pt][2 * e + 1] = bfhi(uu[e]); }
#pragma unroll
            for (int i = 0; i < 16; ++i) o[pt][i] = 0.f;
        }
        const float gl = __expf(U.gl);
        if (n + 2 < N) uload(n + 2, U);
#pragma unroll
        for (int ks = 0; ks < 8; ++ks) {
            const bf16x8 sb = pack8(S[ks >> 1], ks & 1);
            const int off = (ks * 16 + 4 * hh) * 2;
#pragma unroll
            for (int pt = 0; pt < 2; ++pt) {
                const char* wr = buf + SL_W + (pt * 32 + r32) * 264 + off;
                const char* qr = buf + SL_QG + (pt * 32 + r32) * 264 + off;
                vn[pt] = MFMA32(ld2x64(wr, wr + 16), sb, vn[pt]);
                o[pt] = MFMA32(ld2x64(qr, qr + 16), sb, o[pt]);
            }
        }
        bf16x8 vb[4];
#pragma unroll
        for (int kp = 0; kp < 4; ++kp) vb[kp] = pack8(vn[kp >> 1], kp & 1);
#pragma unroll
        for (int d = 0; d < 4; ++d) S[d] = S[d] * gl;
#pragma unroll
        for (int kp = 0; kp < 4; ++kp) {
            const int off = (kp * 16 + 4 * hh) * 2;
#pragma unroll
            for (int pt = 0; pt < 2; ++pt) { const char* ar = buf + SL_AT + (pt * 32 + r32) * 136 + off; o[pt] = MFMA32(ld2x64(ar, ar + 16), vb[kp], o[pt]); }
#pragma unroll
            for (int d = 0; d < 4; ++d) { const char* kr = buf + SL_KDT + (d * 32 + r32) * 136 + off; S[d] = MFMA32(ld2x64(kr, kr + 16), vb[kp], S[d]); }
        }
        const int cn = dir ? N - 1 - n : n; const size_t mrow0 = (size_t)(gch0 + cn) * 64;
#pragma unroll
        for (int pt = 0; pt < 2; ++pt)
#pragma unroll
            for (int i = 0; i < 16; ++i) {
                const int pi = pt * 32 + crow(i, hh), tl = dir ? 63 - pi : pi;
                Oout[(mrow0 + tl) * 512 + h * 128 + slab * 32 + r32] = f2bf(o[pt][i]);
            }
    };
    __syncthreads();
    if (loader) {
        LRegs RA, RB;
        issue(0, RA); issue(1, RB); commit(0, RA); issue(2, RA);
        __syncthreads();
        for (int n = 0; n < N; n += 2) {
            commit(1, RB); if (n + 3 < N) issue(n + 3, RB);
            __syncthreads();
            if (n + 2 < N) { commit(0, RA); if (n + 4 < N) issue(n + 4, RA); }
            __syncthreads();
        }
    } else {
        URegs UA, UB;
        uload(0, UA); uload(1, UB);
        __syncthreads();
        for (int n = 0; n < N; n += 2) {
            compute(n, 0, UA);
            __syncthreads();
            compute(n + 1, 1, UB);
            __syncthreads();
        }
    }
    asm volatile("s_waitcnt vmcnt(0)" ::: "memory");
    __syncthreads();
    if (tid == 0) {
        __builtin_amdgcn_fence(__ATOMIC_RELEASE, "agent");
        asm volatile("s_waitcnt vmcnt(0)" ::: "memory");
        const int sidx = seqbase < MP ? (seqbase >> 11) : 32 + ((seqbase - MP) >> 14);
        __hip_atomic_fetch_add((unsigned*)(ws + OFF_CTR + 2048) + sidx, 1u, __ATOMIC_RELAXED, __HIP_MEMORY_SCOPE_AGENT);
    }
}

constexpr int LDA_ = 1024, LDO_ = 1024;
constexpr size_t SHM_V = 64 * 128 * 2, SHM_K = 64 * 128 * 2;
#define KSWZ(row, colB) ((row) * 256 + ((colB) ^ (((row) & 7) << 4)))
#define SBAR() __builtin_amdgcn_sched_barrier(0)

DI unsigned cvtpk_a(float lo, float hi) { unsigned r; asm volatile("v_cvt_pk_bf16_f32 %0, %1, %2" : "=v"(r) : "v"(lo), "v"(hi)); return r; }
DI float smA_max0(const f32x16& p0) {
    float mx = p0[0];
#pragma unroll
    for (int r = 1; r < 16; ++r) mx = fmaxf(mx, p0[r]);
    return mx;
}
DI float smA_max1(float mx, const f32x16& p1) {
#pragma unroll
    for (int r = 0; r < 16; ++r) mx = fmaxf(mx, p1[r]);
    auto rr = __builtin_amdgcn_permlane32_swap(__float_as_uint(mx), __float_as_uint(mx), false, false);
    return fmaxf(__uint_as_float(rr[0]), __uint_as_float(rr[1]));
}
template <int LO> DI void smA_exp(f32x16& p0) {
#pragma unroll
    for (int r = LO; r < LO + 8; ++r) p0[r] = __builtin_amdgcn_exp2f(p0[r]);
}
template <bool FIRST> DI void smB(f32x16& p0, f32x16& p1, float pmax, float& m_reg, float& alpha) {
    if (!FIRST && __builtin_expect(__all(pmax <= ATHR2), 1)) { alpha = 1.f; }
    else {
        const float delta = FIRST ? pmax : fmaxf(pmax, 0.f);
        alpha = __builtin_amdgcn_exp2f(-delta); m_reg += delta;
#pragma unroll
        for (int r = 0; r < 16; ++r) { p0[r] *= alpha; p1[r] -= delta; }
    }
}
template <bool FIRST> DI void partialSM(f32x16& p0, f32x16& p1, float& m_reg, float& alpha) {
    const float pmax = smA_max1(smA_max0(p0), p1);
    smA_exp<0>(p0); smA_exp<8>(p0);
    smB<FIRST>(p0, p1, pmax, m_reg, alpha);
}
DI void finishSM(f32x16& p0, f32x16& p1, float alpha, float& l_reg, bf16x8& pa0, bf16x8& pa1, bf16x8& pa2, bf16x8& pa3) {
#pragma unroll
    for (int r = 0; r < 16; ++r) p1[r] = __builtin_amdgcn_exp2f(p1[r]);
    float ps = 0;
#pragma unroll
    for (int r = 0; r < 16; ++r) ps += p0[r];
#pragma unroll
    for (int r = 0; r < 16; ++r) ps += p1[r];
    { auto rr = __builtin_amdgcn_permlane32_swap(__float_as_uint(ps), __float_as_uint(ps), false, false);
      ps = __uint_as_float(rr[0]) + __uint_as_float(rr[1]); }
    l_reg = l_reg * alpha + ps;
#define PK4(P, BASE, OUT) do { unsigned a0 = cvtpk_a(P[BASE + 0], P[BASE + 1]), a1 = cvtpk_a(P[BASE + 2], P[BASE + 3]);   \
    unsigned b0 = cvtpk_a(P[BASE + 4], P[BASE + 5]), b1 = cvtpk_a(P[BASE + 6], P[BASE + 7]);                              \
    auto r0 = __builtin_amdgcn_permlane32_swap(a0, b0, false, false); auto r1 = __builtin_amdgcn_permlane32_swap(a1, b1, false, false); \
    u32x4 w = {r0[0], r1[0], r0[1], r1[1]}; OUT = __builtin_bit_cast(bf16x8, w); } while (0)
    PK4(p0, 0, pa0); PK4(p0, 8, pa1); PK4(p1, 0, pa2); PK4(p1, 8, pa3);
#undef PK4
}
DI void qkt(f32x16& p0, f32x16& p1, const char* Ks, const bf16x8* qr, float negm, int r32, int hi) {
#pragma unroll
    for (int i = 0; i < 16; ++i) { p0[i] = negm; p1[i] = negm; }
#pragma unroll
    for (int d0 = 0; d0 < 8; ++d0) { const int cb = (d0 * 16 + hi * 8) * 2;
        bf16x8 b0 = *(const bf16x8*)(Ks + KSWZ(r32, cb));
        bf16x8 b1 = *(const bf16x8*)(Ks + KSWZ(32 + r32, cb));
        p0 = MFMA32(b0, qr[d0], p0);
        p1 = MFMA32(b1, qr[d0], p1); }
}
DI int v_st(int k, int c) { const int kk = (k & ~0xC) | ((k & 4) << 1) | ((k & 8) >> 1); return ((kk >> 3) * 4 + (c >> 5)) * 512 + ((kk & 7) * 32 + (c & 31)) * 2; }
DI int v_rd_base(int lane) { return ((lane & 3) << 3) | (((lane >> 2) & 3) << 6) | (((lane >> 4) & 1) << 5) | (((lane >> 5) & 1) << 8); }
constexpr int v_rd_off(int d0, int ks, int half) { return d0 * 512 + ks * 4096 + half * 2048; }
template <int OFF> DI s16x4 tr_read(int vb) { s16x4 r; asm volatile("ds_read_b64_tr_b16 %0, %1 offset:%2" : "=&v"(r) : "v"(vb), "i"(OFF) : "memory"); return r; }
template <int D0> DI void pv_one(f32x16& od, int vb, bf16x8 pa0, bf16x8 pa1, bf16x8 pa2, bf16x8 pa3) {
    const s16x4 l0 = tr_read<v_rd_off(D0, 0, 0)>(vb), h0 = tr_read<v_rd_off(D0, 0, 1)>(vb), l1 = tr_read<v_rd_off(D0, 1, 0)>(vb), h1 = tr_read<v_rd_off(D0, 1, 1)>(vb);
    const s16x4 l2 = tr_read<v_rd_off(D0, 2, 0)>(vb), h2 = tr_read<v_rd_off(D0, 2, 1)>(vb), l3 = tr_read<v_rd_off(D0, 3, 0)>(vb), h3 = tr_read<v_rd_off(D0, 3, 1)>(vb);
    asm volatile("s_waitcnt lgkmcnt(0)" ::: "memory"); SBAR();
#define PK(L, H) (bf16x8){L[0], L[1], L[2], L[3], H[0], H[1], H[2], H[3]}
    od = MFMA32(pa0, PK(l0, h0), od);
    od = MFMA32(pa1, PK(l1, h1), od);
    od = MFMA32(pa2, PK(l2, h2), od);
    od = MFMA32(pa3, PK(l3, h3), od);
#undef PK
}
DI float pv_d0_sm(f32x16* o, int vb, bf16x8 pa0, bf16x8 pa1, bf16x8 pa2, bf16x8 pa3, f32x16& q0, f32x16& q1) {
    pv_one<0>(o[0], vb, pa0, pa1, pa2, pa3); const float mx0 = smA_max0(q0);
    pv_one<1>(o[1], vb, pa0, pa1, pa2, pa3); const float pmax = smA_max1(mx0, q1);
    pv_one<2>(o[2], vb, pa0, pa1, pa2, pa3); smA_exp<0>(q0);
    pv_one<3>(o[3], vb, pa0, pa1, pa2, pa3); smA_exp<8>(q0);
    return pmax;
}
DI void pv_d0(f32x16* o, int vb, bf16x8 pa0, bf16x8 pa1, bf16x8 pa2, bf16x8 pa3) {
    pv_one<0>(o[0], vb, pa0, pa1, pa2, pa3); pv_one<1>(o[1], vb, pa0, pa1, pa2, pa3); pv_one<2>(o[2], vb, pa0, pa1, pa2, pa3); pv_one<3>(o[3], vb, pa0, pa1, pa2, pa3);
}

DI void attn_unit(const bf16_t* __restrict__ Qb, const bf16_t* __restrict__ Kh, const bf16_t* __restrict__ Vh, bf16_t* __restrict__ Ob, const float* __restrict__ onw, int seq, char* lds) {
    int tid_ = threadIdx.x; asm volatile("" : "+v"(tid_));
    const int tid = tid_, wid = tid >> 6, lane = tid & 63, r32 = lane & 31, hi = lane >> 5;
    char* V_lds = lds; char* K_lds = lds + 2 * SHM_V;
    float* wsf = (float*)(lds + 2 * SHM_V + 2 * SHM_K) + wid * 64; float* li_l = wsf; float* al_l = wsf + 32;
    float m_reg = 0.f, l_reg = 0; f32x16 o[4]; bf16x8 qr[8];
#pragma unroll
    for (int d = 0; d < 4; ++d)
#pragma unroll
        for (int i = 0; i < 16; ++i) o[d][i] = 0.f;
    const bf16_t* Qw = Qb + (long)((wid & 3) * 32 + r32) * LDA_ + (wid >> 2) * 128 + hi * 8;
#pragma unroll
    for (int d0 = 0; d0 < 8; ++d0) qr[d0] = *(const bf16x8*)(Qw + d0 * 16);
    const int sr = tid >> 4, sc = (tid & 15) * 8, vst0 = v_st(sr, sc), vst1 = v_st(32 + sr, sc);
    const int vb0 = (int)(uintptr_t)V_lds + v_rd_base(lane);
    struct { bf16x8 vs0, vs1, ks0, ks1; } sr_[1];
#define SLOAD(i, k0) do { sr_[i].vs0 = *(const bf16x8*)(&Vh[(long)((k0) + sr) * LDA_ + sc]); sr_[i].vs1 = *(const bf16x8*)(&Vh[(long)((k0) + 32 + sr) * LDA_ + sc]); \
    sr_[i].ks0 = *(const bf16x8*)(&Kh[(long)((k0) + sr) * LDA_ + sc]); sr_[i].ks1 = *(const bf16x8*)(&Kh[(long)((k0) + 32 + sr) * LDA_ + sc]); } while (0)
#define SWRITE(b, i) do { *(bf16x8*)(V_lds + (b) * SHM_V + vst0) = sr_[i].vs0;          \
    *(bf16x8*)(V_lds + (b) * SHM_V + vst1) = sr_[i].vs1; int kc = sc * 2;               \
    *(bf16x8*)(K_lds + (b) * SHM_K + KSWZ(sr, kc)) = sr_[i].ks0;                       \
    *(bf16x8*)(K_lds + (b) * SHM_K + KSWZ(32 + sr, kc)) = sr_[i].ks1; } while (0)
#define SWAIT() asm volatile("s_waitcnt vmcnt(0)" ::: "memory")
#define RESC(a) do { if (__any((a) < 1.f)) { if (hi == 0) al_l[r32] = (a); asm volatile("s_waitcnt lgkmcnt(0)" ::: "memory"); \
    _Pragma("unroll") for (int d = 0; d < 4; ++d) _Pragma("unroll") for (int r = 0; r < 16; ++r) o[d][r] *= al_l[crow(r, hi)]; } } while (0)
    f32x16 pA0, pA1, pB0, pB1; float alA, alB; bf16x8 pa0, pa1, pa2, pa3; const int NT = seq / 64;
    constexpr int SE = 0, SO = 0;
    SLOAD(SE, 0); asm volatile("s_waitcnt vmcnt(0)" ::: "memory"); SWRITE(0, SE); __syncthreads();
    qkt(pA0, pA1, K_lds, qr, 0.f, r32, hi); partialSM<true>(pA0, pA1, m_reg, alA);
    SLOAD(SO, 64);
    SWAIT(); SWRITE(1, SO); __syncthreads();
    for (int j = 1; j + 1 < NT; j += 2) {
        SBAR(); qkt(pB0, pB1, K_lds + SHM_K, qr, -m_reg, r32, hi);
        finishSM(pA0, pA1, alA, l_reg, pa0, pa1, pa2, pa3); SBAR();
        SLOAD(SO, (j + 1) * 64); SBAR();
        { const float pm = pv_d0_sm(o, vb0, pa0, pa1, pa2, pa3, pB0, pB1); smB<false>(pB0, pB1, pm, m_reg, alB); }
        __syncthreads(); SWAIT(); SWRITE(0, SE);
        RESC(alB); __syncthreads();
        SBAR(); qkt(pA0, pA1, K_lds, qr, -m_reg, r32, hi);
        finishSM(pB0, pB1, alB, l_reg, pa0, pa1, pa2, pa3); SBAR();
        SLOAD(SE, (j + 2) * 64); SBAR();
        { const float pm = pv_d0_sm(o, vb0 + (int)SHM_V, pa0, pa1, pa2, pa3, pA0, pA1); smB<false>(pA0, pA1, pm, m_reg, alA); }
        __syncthreads(); SWAIT(); SWRITE(1, SO);
        RESC(alA); __syncthreads();
    }
    SBAR(); qkt(pB0, pB1, K_lds + SHM_K, qr, -m_reg, r32, hi);
    finishSM(pA0, pA1, alA, l_reg, pa0, pa1, pa2, pa3); SBAR();
    { const float pm = pv_d0_sm(o, vb0, pa0, pa1, pa2, pa3, pB0, pB1); smB<false>(pB0, pB1, pm, m_reg, alB); }
    __syncthreads(); RESC(alB);
    finishSM(pB0, pB1, alB, l_reg, pa0, pa1, pa2, pa3); SBAR();
    pv_d0(o, vb0 + (int)SHM_V, pa0, pa1, pa2, pa3);
    if (hi == 0) li_l[r32] = l_reg; asm volatile("s_waitcnt lgkmcnt(0)" ::: "memory");
    float wn[4];
#pragma unroll
    for (int d0 = 0; d0 < 4; ++d0) wn[d0] = onw[d0 * 32 + r32];
    bf16_t* Ow = Ob + (long)((wid & 3) * 32) * LDO_ + (wid >> 2) * 128;
#pragma unroll
    for (int r = 0; r < 16; ++r) {
        const int orow = crow(r, hi);
        const float rl = __builtin_amdgcn_rcpf(li_l[orow]);
        float v[4]; float ss = 0.f;
#pragma unroll
        for (int d0 = 0; d0 < 4; ++d0) { v[d0] = o[d0][r] * rl; ss += v[d0] * v[d0]; }
#pragma unroll
        for (int of = 16; of >= 1; of >>= 1) ss += __shfl_xor(ss, of);
        const float rs = rsqrtf(ss * (1.f / 128.f) + 1e-6f);
#pragma unroll
        for (int d0 = 0; d0 < 4; ++d0) Ow[(long)orow * LDO_ + d0 * 32 + r32] = f2bf(v[d0] * rs * wn[d0]);
    }
#undef SLOAD
#undef SWRITE
#undef SWAIT
#undef RESC
}

DI void dn_combine_range(const Params& p, int u_begin, int u_end, int gid, int ng) {
    char* ws = p.ws;
    const bf16_t* of = (const bf16_t*)(ws + OFF_OF); const bf16_t* ob = (const bf16_t*)(ws + OFF_OB); const bf16_t* z = (const bf16_t*)(ws + OFF_Z);
    bf16_t* mix = (bf16_t*)(ws + OFF_MIX);
    const int j = threadIdx.x & 15;
    float nw[8];
#pragma unroll
    for (int e = 0; e < 8; ++e) nw[e] = p.dn_norm_w[j * 8 + e];
    for (int u0 = u_begin + gid; u0 < u_end; u0 += 2 * ng) {
        u32x4 a[2], b[2], zz[2]; bool ok[2];
#pragma unroll
        for (int q = 0; q < 2; ++q) {
            const int u = u0 + q * ng; ok[q] = u < u_end;
            if (ok[q]) { const size_t off = (size_t)u * 128 + j * 8; a[q] = *(const u32x4*)(of + off); b[q] = *(const u32x4*)(ob + off); zz[q] = *(const u32x4*)(z + off); }
            else { a[q] = (u32x4){0u, 0u, 0u, 0u}; b[q] = a[q]; zz[q] = a[q]; }
        }
#pragma unroll
        for (int q = 0; q < 2; ++q) {
            const int u = u0 + q * ng;
            const unsigned aa[4] = {a[q].x, a[q].y, a[q].z, a[q].w}, bb[4] = {b[q].x, b[q].y, b[q].z, b[q].w}, zq[4] = {zz[q].x, zz[q].y, zz[q].z, zz[q].w};
            float v[8], zf[8]; float ss = 0.f;
#pragma unroll
            for (int e = 0; e < 4; ++e) { v[2 * e] = bflo(aa[e]) + bflo(bb[e]); v[2 * e + 1] = bfhi(aa[e]) + bfhi(bb[e]); zf[2 * e] = bflo(zq[e]); zf[2 * e + 1] = bfhi(zq[e]); }
#pragma unroll
            for (int e = 0; e < 8; ++e) ss += v[e] * v[e];
#pragma unroll
            for (int o = 8; o >= 1; o >>= 1) ss += __shfl_xor(ss, o);
            const float rs = rsqrtf(ss * (1.f / 128.f) + 1e-6f);
            float r[8];
#pragma unroll
            for (int e = 0; e < 8; ++e) r[e] = v[e] * rs * nw[e] * silu_f(zf[e]);
            if (ok[q]) *(u32x4*)(mix + (size_t)(u >> 2) * 1024 + 512 + (u & 3) * 128 + j * 8) = (u32x4){cvtpk(r[0], r[1]), cvtpk(r[2], r[3]), cvtpk(r[4], r[5]), cvtpk(r[6], r[7])};
        }
    }
}

DI void phase_ffn_act(const Params& p, int slab) {
    char* ws = p.ws;
    const bf16_t* us = (const bf16_t*)(ws + OFF_US); bf16_t* act = (bf16_t*)(ws + OFF_ACT);
    constexpr int NG = DFFP / 8;
    const int nthreads = gridDim.x * NTHR, tpg = nthreads / NG;
    const int gt = blockIdx.x * NTHR + threadIdx.x, cg8 = gt % NG, sidx = gt / NG;
    if (sidx >= tpg) return;
    const int seglen = (MSLAB + tpg - 1) / tpg;
    const int t_beg = sidx * seglen, t_end = min(MSLAB, t_beg + seglen);
    const int c8 = cg8 * 8, m0 = slab * MSLAB;
    if (c8 >= DFF) { for (int ml = t_beg; ml < t_end; ++ml) *(u32x4*)(act + (size_t)ml * DFFP + c8) = (u32x4){0u, 0u, 0u, 0u}; return; }
    float wg[3][8], wu[3][8], bg[8], bu[8];
#pragma unroll
    for (int e = 0; e < 8; ++e) { bg[e] = p.ffn_conv_b[c8 + e]; bu[e] = p.ffn_conv_b[DFF + c8 + e]; }
#pragma unroll
    for (int j = 0; j < 3; ++j)
#pragma unroll
        for (int e = 0; e < 8; ++e) { wg[j][e] = p.ffn_conv_w[(size_t)j * DFF2 + c8 + e]; wu[j][e] = p.ffn_conv_w[(size_t)j * DFF2 + DFF + c8 + e]; }
    auto ldrow = [&](int ml, u32x4& g, u32x4& u) {
        if (ml >= 0 && ml < MSLAB) { const bf16_t* row = us + (size_t)ml * DFF2; g = *(const u32x4*)(row + c8); u = *(const u32x4*)(row + DFF + c8); }
        else { g = (u32x4){0u, 0u, 0u, 0u}; u = g; }
    };
    u32x4 gp, up, gc, uc, gn, un, gn2, un2, gn3, un3, gn4, un4;
    ldrow(t_beg - 1, gp, up); ldrow(t_beg, gc, uc); ldrow(t_beg + 1, gn, un); ldrow(t_beg + 2, gn2, un2); ldrow(t_beg + 3, gn3, un3);
    for (int ml = t_beg; ml < t_end; ++ml) {
        ldrow(ml + 4, gn4, un4);
        int base, t, T; seq_of(m0 + ml, base, t, T);
        const float mp = t > 0 ? 1.f : 0.f, mn = t + 1 < T ? 1.f : 0.f;
        const unsigned gpa[4] = {gp.x, gp.y, gp.z, gp.w}, gca[4] = {gc.x, gc.y, gc.z, gc.w}, gna[4] = {gn.x, gn.y, gn.z, gn.w};
        const unsigned upa[4] = {up.x, up.y, up.z, up.w}, uca[4] = {uc.x, uc.y, uc.z, uc.w}, una[4] = {un.x, un.y, un.z, un.w};
        float r[8];
#pragma unroll
        for (int e = 0; e < 4; ++e) {
            const float g0 = bg[2 * e] + mp * bflo(gpa[e]) * wg[0][2 * e] + bflo(gca[e]) * wg[1][2 * e] + mn * bflo(gna[e]) * wg[2][2 * e];
            const float g1 = bg[2 * e + 1] + mp * bfhi(gpa[e]) * wg[0][2 * e + 1] + bfhi(gca[e]) * wg[1][2 * e + 1] + mn * bfhi(gna[e]) * wg[2][2 * e + 1];
            const float u0 = bu[2 * e] + mp * bflo(upa[e]) * wu[0][2 * e] + bflo(uca[e]) * wu[1][2 * e] + mn * bflo(una[e]) * wu[2][2 * e];
            const float u1 = bu[2 * e + 1] + mp * bfhi(upa[e]) * wu[0][2 * e + 1] + bfhi(uca[e]) * wu[1][2 * e + 1] + mn * bfhi(una[e]) * wu[2][2 * e + 1];
            r[2 * e] = silu_f(g0) * u0; r[2 * e + 1] = silu_f(g1) * u1;
        }
        *(u32x4*)(act + (size_t)ml * DFFP + c8) = (u32x4){cvtpk(r[0], r[1]), cvtpk(r[2], r[3]), cvtpk(r[4], r[5]), cvtpk(r[6], r[7])};
        gp = gc; up = uc; gc = gn; uc = un; gn = gn2; un = un2; gn2 = gn3; un2 = un3; gn3 = gn4; un3 = un4;
    }
}

constexpr int NPHASE = 14;
constexpr int Q_DNS = 16, Q_ATS = 512, Q_DNP = 256, Q_ATP = 1024, Q_CMB = M_TOK / 256, Q_TOTAL = Q_DNS + Q_ATS + Q_DNP + Q_ATP + Q_CMB;

DI void run_phase(const Params& p, int ph, char* lds) {
    char* ws = p.ws;
    switch (ph) {
    case 0: phase0(p, lds); break;
    case 1: {
        FInProj f{(bf16_t*)((char*)p.out + 2 * U1), (bf16_t*)(ws + OFF_PROJD), (bf16_t*)(ws + OFF_Z), (float*)(ws + OFF_GATES)};
        run_gemm(lds, (const bf16_t*)p.out, (const bf16_t*)(ws + OFF_WIN), 1024, M_TOK / 256, INWP / 256, f);
    } break;
    case 2: {
        phase_attn_prep(p);
        {
            u32x2 xr[20];
#pragma unroll
            for (int r = 0; r < 20; ++r) xr[r] = (u32x2){0u, 0u};
            if ((int)blockIdx.x < NCHUNK * 4) dn_prep_load(p, blockIdx.x >> 2, blockIdx.x & 3, xr);
            for (int u = blockIdx.x; u < NCHUNK * 4; u += gridDim.x) {
                const int un = u + gridDim.x;
                dn_prep_unit(p, u >> 2, u & 3, lds, xr, un < NCHUNK * 4 ? (un >> 2) : -1, un & 3);
            }
        }
    } break;
    case 3: {
        unsigned* ctr = (unsigned*)(ws + OFF_CTR);
        int* item_s = (int*)(lds + LDS_BYTES - 16);
        const bf16_t* bufA = (const bf16_t*)((char*)p.out + 2 * U1);
        bf16_t* ao = (bf16_t*)(ws + OFF_MIX);
        for (;;) {
            __syncthreads();
            if (threadIdx.x == 0) *item_s = (int)atomicAdd(ctr, 1u);
            __syncthreads();
            const int it = __builtin_amdgcn_readfirstlane(*item_s);
            if (it >= Q_TOTAL) break;
#ifndef SKIP_SCAN
            if (it < Q_DNS) { const int sq = it >> 3; dn_scan_item(p, MP + sq * 16384, 16384, (it >> 1) & 3, it & 1, lds); }
#else
            if (it < Q_DNS) {}
#endif
            else if (it >= Q_DNS + Q_ATS + Q_DNP + Q_ATP) {
                const int c = it - (Q_DNS + Q_ATS + Q_DNP + Q_ATP), tok0 = c * 256;
                const int sidx = tok0 < MP ? (tok0 >> 11) : 32 + ((tok0 - MP) >> 14);
                if (threadIdx.x == 0) {
                    unsigned* dp = (unsigned*)(ws + OFF_CTR + 2048) + sidx;
                    while (__hip_atomic_load(dp, __ATOMIC_RELAXED, __HIP_MEMORY_SCOPE_AGENT) < 8u) __builtin_amdgcn_s_sleep(8);
                    __builtin_amdgcn_fence(__ATOMIC_ACQUIRE, "agent");
                    asm volatile("s_waitcnt vmcnt(0)" ::: "memory");
                }
                __syncthreads();
                dn_combine_range(p, tok0 * 4, tok0 * 4 + 1024, threadIdx.x >> 4, NTHR >> 4);
            }
            else if (it >= Q_DNS + Q_ATS && it < Q_DNS + Q_ATS + Q_DNP) {
#ifndef SKIP_SCAN
                const int u = it - Q_DNS - Q_ATS; dn_scan_item(p, (u >> 3) * 2048, 2048, (u >> 1) & 3, u & 1, lds);
#endif
            } else {
                size_t r0; int kvh, qb, seq;
                if (it < Q_DNS + Q_ATS) { const int u = it - Q_DNS, bk = u >> 7; qb = u & 127; kvh = bk & 1; r0 = (size_t)MP + (size_t)(bk >> 1) * 16384; seq = 16384; }
                else { const int u = it - Q_DNS - Q_ATS - Q_DNP, bk = u >> 4; qb = u & 15; kvh = bk & 1; r0 = (size_t)(bk >> 1) * 2048; seq = 2048; }
#ifndef SKIP_ATTN
                attn_unit(bufA + (r0 + qb * 128) * 1024 + kvh * 256, bufA + r0 * 1024 + 512 + kvh * 128, bufA + r0 * 1024 + 768 + kvh * 128,
                          ao + (r0 + qb * 128) * 1024 + kvh * 256, p.o_norm_w, seq, lds);
#endif
            }
        }
    } break;
    case 4: break;
    case 5: {
        pg8::Gemm g{(const bf16_t*)(ws + OFF_MIX), (const bf16_t*)(ws + OFF_WOUT), M_TOK, 1024, 1024};
        pg8::XcdOrder S; S.init(M_TOK / 256, 4);
        EpiOutProj E{p.x_prompt, p.x_sample, p.out, (bf16_t*)(ws + OFF_H2), (float*)(ws + OFF_SS)};
        pg8::gemm_phase<EpiOutProj, pg8::XcdOrder, true, true>((PG8_LAS unsigned char*)lds, g, S, E);
    } break;
    case 6: break;
    case 7: case 10: {
        const int slab = ph == 7 ? 0 : 1;
        FU f{(bf16_t*)(ws + OFF_US), (const float*)(ws + OFF_SS) + (size_t)slab * MSLAB};
        run_gemm(lds, (const bf16_t*)(ws + OFF_H2) + (size_t)slab * MSLAB * 1024, (const bf16_t*)(ws + OFF_WFFI), 1024, MSLAB / 256, DFF2P / 256, f);
    } break;
    case 8: case 11: phase_ffn_act(p, ph == 8 ? 0 : 1); break;
    case 9: case 12: {
        const int slab = ph == 9 ? 0 : 1;
        FResOut f{p.out + (size_t)slab * MSLAB * DM};
        run_gemm(lds, (const bf16_t*)(ws + OFF_ACT), (const bf16_t*)(ws + OFF_WFFO), DFFP, MSLAB / 256, 4, f);
    } break;
    default: break;
    }
}

DI void grid_bar(unsigned* ctr, unsigned target) {
    asm volatile("s_waitcnt vmcnt(0)" ::: "memory");
    __syncthreads();
    if (threadIdx.x == 0) {
        __builtin_amdgcn_fence(__ATOMIC_RELEASE, "agent");
        asm volatile("s_waitcnt vmcnt(0)" ::: "memory");
        __hip_atomic_fetch_add(ctr, 1u, __ATOMIC_RELAXED, __HIP_MEMORY_SCOPE_AGENT);
        while (__hip_atomic_load(ctr, __ATOMIC_RELAXED, __HIP_MEMORY_SCOPE_AGENT) < target) __builtin_amdgcn_s_sleep(4);
        __builtin_amdgcn_fence(__ATOMIC_ACQUIRE, "agent");
        asm volatile("s_waitcnt vmcnt(0)" ::: "memory");
    }
    __syncthreads();
}

__global__ void __launch_bounds__(NTHR) mega(Params p, int ph0, int ph1) {
    extern __shared__ __attribute__((aligned(16))) char lds[];
    cg::grid_group grid = cg::this_grid();
#ifdef ONLY_PH
    run_phase(p, ONLY_PH, lds);
#else
    unsigned* bar = (unsigned*)(p.ws + OFF_CTR + 1024);
    run_phase(p, 0, lds); grid.sync();
    run_phase(p, 1, lds); grid_bar(bar, 1u * gridDim.x);
    run_phase(p, 2, lds); grid_bar(bar, 2u * gridDim.x);
    run_phase(p, 3, lds); grid_bar(bar, 3u * gridDim.x);
    run_phase(p, 5, lds); grid_bar(bar, 4u * gridDim.x);
    run_phase(p, 7, lds); grid_bar(bar, 5u * gridDim.x);
    run_phase(p, 8, lds); grid_bar(bar, 6u * gridDim.x);
    run_phase(p, 9, lds);
    run_phase(p, 10, lds); grid_bar(bar, 7u * gridDim.x);
    run_phase(p, 11, lds); grid_bar(bar, 8u * gridDim.x);
    run_phase(p, 12, lds);
#endif
}

extern "C" void kernel_launch(void* const* d_in, const int* in_sizes, int n_in, void* d_out, int out_size, void* d_ws, size_t ws_size, hipStream_t stream) {
    static int grid_blocks = 0;
    if (!grid_blocks) {
        hipFuncSetAttribute((const void*)mega, hipFuncAttributeMaxDynamicSharedMemorySize, LDS_BYTES);
        int dev = 0, cus = 0, per_cu = 0;
        hipGetDevice(&dev);
        hipDeviceGetAttribute(&cus, hipDeviceAttributeMultiprocessorCount, dev);
        hipOccupancyMaxActiveBlocksPerMultiprocessor(&per_cu, mega, NTHR, LDS_BYTES);
        if (per_cu < 1) per_cu = 1;
        grid_blocks = cus;
        if (grid_blocks % 8) grid_blocks -= grid_blocks % 8;
    }
    Params p{};
    p.x_prompt = (const float*)d_in[0]; p.x_sample = (const float*)d_in[1]; p.norm1_w = (const float*)d_in[2]; p.w_in = (const float*)d_in[3];
    p.dn_conv_w = (const float*)d_in[4]; p.A_log_f = (const float*)d_in[5]; p.A_log_b = (const float*)d_in[6]; p.dt_f = (const float*)d_in[7];
    p.dt_b = (const float*)d_in[8]; p.dn_norm_w = (const float*)d_in[9]; p.q_norm_w = (const float*)d_in[10]; p.k_norm_w = (const float*)d_in[11];
    p.o_norm_w = (const float*)d_in[12]; p.w_out = (const float*)d_in[13]; p.norm2_w = (const float*)d_in[14]; p.w_ffn_in = (const float*)d_in[15];
    p.ffn_conv_w = (const float*)d_in[16]; p.ffn_conv_b = (const float*)d_in[17]; p.w_ffn_out = (const float*)d_in[18];
    p.out = (float*)d_out; p.ws = (char*)d_ws;
    hipMemsetAsync((char*)d_ws + OFF_CTR, 0, 4096, stream);
    int ph0 = 0, ph1 = NPHASE - 1;
    void* args[] = {&p, &ph0, &ph1};
    hipError_t e = hipLaunchCooperativeKernel((void*)mega, dim3(grid_blocks), dim3(NTHR), args, LDS_BYTES, stream);
    if (e != hipSuccess) fprintf(stderr, "cooperative launch failed: %s (grid %d)\n", hipGetErrorString(e), grid_blocks);
}
```
